# Optimizing an MI355X kernel written in HIP

```python
import jax, jax.numpy as jnp
from jax import lax
import numpy as np

D_MODEL = 1024
BATCH = 2
SEQ = 8192
DEPTH = 2

N_HEADS = 8
HEAD_DIM = 128
ATTN_WIDTH = N_HEADS * HEAD_DIM
ROT_DIM = HEAD_DIM // 4
ROPE_THETA = 500000.0
MOBA_BLOCK = 256
MOBA_TOPK = 3
Q_CHUNK = 32
CONV_WIDTH = D_MODEL
CONV_KERNEL = 31
N_BRANCH = 2
SPLIT_SIZES = (ATTN_WIDTH, ATTN_WIDTH, ATTN_WIDTH, ATTN_WIDTH,
               2 * CONV_WIDTH, CONV_WIDTH, N_BRANCH * D_MODEL)
N_IN = sum(SPLIT_SIZES)
SPLIT_POINTS = tuple(int(v) for v in np.cumsum(SPLIT_SIZES)[:-1])
EPS = 1e-6

kernel_name = "moba_conformer_gated_hybrid"


def rms_norm(t, g):
    tf = t.astype(jnp.float32)
    y = tf * lax.rsqrt(jnp.mean(tf * tf, axis=-1, keepdims=True) + EPS)
    return (y * g.astype(jnp.float32)).astype(t.dtype)


def layer_norm(t, g, b):
    tf = t.astype(jnp.float32)
    mu = jnp.mean(tf, axis=-1, keepdims=True)
    var = jnp.mean(jnp.square(tf - mu), axis=-1, keepdims=True)
    y = (tf - mu) * lax.rsqrt(var + EPS)
    return (y * g.astype(jnp.float32) + b.astype(jnp.float32)).astype(t.dtype)


def rope_tables(seq):
    inv_freq = ROPE_THETA ** (-jnp.arange(0, ROT_DIM, 2, dtype=jnp.float32) / ROT_DIM)
    ang = jnp.arange(seq, dtype=jnp.float32)[:, None] * inv_freq[None, :]
    return jnp.cos(ang), jnp.sin(ang)


def partial_rope(t, cos, sin):
    tf = t.astype(jnp.float32)
    half = ROT_DIM // 2
    t1, t2, rest = tf[..., :half], tf[..., half:ROT_DIM], tf[..., ROT_DIM:]
    out = jnp.concatenate([t1 * cos - t2 * sin, t2 * cos + t1 * sin, rest], axis=-1)
    return out.astype(t.dtype)


def moba_attention(q, k, v):
    B, H, S, D = q.shape
    nb = -(-S // MOBA_BLOCK)
    pad = nb * MOBA_BLOCK - S
    kp = jnp.pad(k, ((0, 0), (0, 0), (0, pad), (0, 0)))
    vp = jnp.pad(v, ((0, 0), (0, 0), (0, pad), (0, 0)))
    kb = kp.reshape(B, H, nb, MOBA_BLOCK, D)
    vb = vp.reshape(B, H, nb, MOBA_BLOCK, D)
    kmean = jnp.mean(kb.astype(jnp.float32), axis=3)
    topk = min(MOBA_TOPK, nb)
    n_chunks = S // Q_CHUNK
    scale = 1.0 / float(np.sqrt(D))
    neg = jnp.finfo(jnp.float32).min
    bi = jnp.arange(B)[:, None, None, None]
    hi = jnp.arange(H)[None, :, None, None]
    qc = q.reshape(B, H, n_chunks, Q_CHUNK, D).transpose(2, 0, 1, 3, 4)

    def chunk(args):
        qi, c = args
        start = c * Q_CHUNK
        blk = start // MOBA_BLOCK
        qpos = start + jnp.arange(Q_CHUNK)
        qf = qi.astype(jnp.float32)
        gate = jnp.einsum('bhqd,bhnd->bhqn', qf, kmean)
        gate = jnp.where(jnp.arange(nb) < blk, gate, neg)
        _, gidx = lax.top_k(gate, topk)
        valid = gidx < blk
        ksel = kb[bi, hi, gidx].astype(jnp.float32)
        vsel = vb[bi, hi, gidx].astype(jnp.float32)
        kown = lax.dynamic_index_in_dim(kb, blk, axis=2, keepdims=False).astype(jnp.float32)
        vown = lax.dynamic_index_in_dim(vb, blk, axis=2, keepdims=False).astype(jnp.float32)
        qs = qf * scale
        l_sel = jnp.einsum('bhqd,bhqtkd->bhqtk', qs, ksel)
        l_sel = jnp.where(valid[..., None], l_sel, neg).reshape(B, H, Q_CHUNK, topk * MOBA_BLOCK)
        kpos = blk * MOBA_BLOCK + jnp.arange(MOBA_BLOCK)
        l_own = jnp.einsum('bhqd,bhkd->bhqk', qs, kown)
        l_own = jnp.where(kpos[None, :] <= qpos[:, None], l_own, neg)
        p = jax.nn.softmax(jnp.concatenate([l_sel, l_own], axis=-1), axis=-1)
        p_sel = p[..., :topk * MOBA_BLOCK].reshape(B, H, Q_CHUNK, topk, MOBA_BLOCK)
        p_own = p[..., topk * MOBA_BLOCK:]
        o = jnp.einsum('bhqtk,bhqtkd->bhqd', p_sel, vsel) + jnp.einsum('bhqk,bhkd->bhqd', p_own, vown)
        return o.astype(q.dtype)

    out = lax.map(chunk, (qc, jnp.arange(n_chunks)))
    return out.transpose(1, 2, 0, 3, 4).reshape(B, H, S, D)


def causal_depthwise_conv(t, w, b):
    C = t.shape[-1]
    y = lax.conv_general_dilated(
        t, w.reshape(CONV_KERNEL, 1, C).astype(t.dtype),
        window_strides=(1,), padding=[(CONV_KERNEL - 1, 0)],
        dimension_numbers=('NWC', 'WIO', 'NWC'), feature_group_count=C)
    return y + b.astype(t.dtype)


def hybrid_layer(x, norm_g, w_in, b_gate, q_norm_g, k_norm_g, conv_w, conv_b,
                 cn_g, cn_b, w_attn_proj, w_conv_proj, w_out, cos, sin):
    B, S, _ = x.shape
    h = rms_norm(x, norm_g)
    proj = h @ w_in
    q, k, v, z_a, u, z_c, gl = jnp.split(proj, SPLIT_POINTS, axis=-1)

    def heads(t):
        return t.reshape(B, S, N_HEADS, HEAD_DIM).transpose(0, 2, 1, 3)

    qh = partial_rope(rms_norm(heads(q), q_norm_g), cos, sin)
    kh = partial_rope(rms_norm(heads(k), k_norm_g), cos, sin)
    o = moba_attention(qh, kh, heads(v)).transpose(0, 2, 1, 3).reshape(B, S, ATTN_WIDTH)
    y_a = (o * jax.nn.silu(z_a)) @ w_attn_proj

    ua, ub = jnp.split(u, 2, axis=-1)
    c = causal_depthwise_conv(ua * jax.nn.sigmoid(ub), conv_w, conv_b)
    c = jax.nn.silu(layer_norm(c, cn_g, cn_b))
    y_c = (c * jax.nn.silu(z_c)) @ w_conv_proj

    g_a, g_c = jnp.split(jax.nn.sigmoid(gl + b_gate), 2, axis=-1)
    return x + (g_a * y_a + g_c * y_c) @ w_out


def setup_inputs(seed: int = 0) -> dict:
    key = jax.random.key(seed)
    ks = jax.random.split(key, 13)
    L = DEPTH
    f32 = jnp.float32
    nrm = lambda k, shape, s: jax.random.normal(k, shape, f32) * s
    return {
        "x": jax.random.normal(ks[0], (BATCH, SEQ, D_MODEL), f32),
        "norm_g": 1.0 + nrm(ks[1], (L, D_MODEL), 0.02),
        "w_in": nrm(ks[2], (L, D_MODEL, N_IN), D_MODEL ** -0.5),
        "b_gate": nrm(ks[3], (L, N_BRANCH * D_MODEL), 0.02),
        "q_norm_g": 1.0 + nrm(ks[4], (L, HEAD_DIM), 0.02),
        "k_norm_g": 1.0 + nrm(ks[5], (L, HEAD_DIM), 0.02),
        "conv_w": nrm(ks[6], (L, CONV_KERNEL, CONV_WIDTH), CONV_KERNEL ** -0.5),
        "conv_b": nrm(ks[7], (L, CONV_WIDTH), 0.02),
        "cn_g": 1.0 + nrm(ks[8], (L, CONV_WIDTH), 0.02),
        "cn_b": nrm(ks[9], (L, CONV_WIDTH), 0.02),
        "w_attn_proj": nrm(ks[10], (L, ATTN_WIDTH, D_MODEL), ATTN_WIDTH ** -0.5),
        "w_conv_proj": nrm(ks[11], (L, CONV_WIDTH, D_MODEL), CONV_WIDTH ** -0.5),
        "w_out": nrm(ks[12], (L, D_MODEL, D_MODEL), D_MODEL ** -0.5),
    }


def reference(x, norm_g, w_in, b_gate, q_norm_g, k_norm_g, conv_w, conv_b,
              cn_g, cn_b, w_attn_proj, w_conv_proj, w_out):
    cos, sin = rope_tables(x.shape[1])
    for l in range(DEPTH):
        x = hybrid_layer(x, norm_g[l], w_in[l], b_gate[l], q_norm_g[l], k_norm_g[l],
                         conv_w[l], conv_b[l], cn_g[l], cn_b[l], w_attn_proj[l],
                         w_conv_proj[l], w_out[l], cos, sin)
    return x
```

```cpp
#include <hip/hip_runtime.h>
#include <cstdio>
#include <cstdint>
namespace pg8 {
#define PG8_LAS __attribute__((address_space(3)))
typedef unsigned short bf16_t;
typedef short bf16x8 __attribute__((ext_vector_type(8)));
typedef float f32x4 __attribute__((ext_vector_type(4)));
typedef unsigned u32x4 __attribute__((ext_vector_type(4)));
constexpr int BM = 256, BK = 64, HALF = 128, HTB = HALF * BK * 2  , STAGE_BYTES = 8 * HTB, NXCD = 8, WGM = 8;

__host__ __device__ __forceinline__ int lds_byte(int r, int c) { const int st = (r >> 4) * 2 + (c >> 5), rr = r & 15, cc = c & 31, ob = rr * 64 + cc * 2; return st * 1024 + (ob ^ (((ob >> 9) & 1) << 5)); }
__host__ __device__ __forceinline__ void stage_rc(int b, int& R, int& C) { const int st = b / 1024, sb = b % 1024, swz = sb ^ (((sb >> 9) & 1) << 5); R = (st >> 1) * 16 + swz / 64; C = (st & 1) * 32 + (swz % 64) / 2; }
__host__ __device__ __forceinline__ int perm32(int rho) { const int n = rho >> 4, i = rho & 15; return 8 * (i >> 2) + 4 * n + (i & 3); }

struct Unit { int pm, pn; };
struct Gemm { const bf16_t* A; const bf16_t* Bt; int M, N, K; };

struct StaticOrder {
    int nM, nN, nwg, G, c;
    __host__ __device__ void init(int M, int N, int G_, int c_) { nM = M / BM; nN = N / BM; nwg = nM * nN; G = G_; c = c_; }
    __host__ __device__ bool next(int i, Unit& u) const {
        const long L = (long)i * G + c; if (L >= nwg) return false;
        int wgid = (int)L; { const int q = nwg / NXCD, r = nwg % NXCD, xcd = wgid % NXCD, off = wgid / NXCD; wgid = (xcd < r ? xcd * (q + 1) : r * (q + 1) + (xcd - r) * q) + off; }
        const int nig = WGM * nN, gid = wgid / nig, fm = gid * WGM, gsz = (nM - fm) < WGM ? (nM - fm) : WGM;
        u.pm = fm + ((wgid % nig) % gsz); u.pn = (wgid % nig) / gsz; return true;
    }
    __device__ __forceinline__ void a_ready(const Unit&) const {}
    __device__ __forceinline__ void done(const Unit&) const {}
};


typedef float f32x2 __attribute__((ext_vector_type(2)));
typedef __bf16 bf16x2_t __attribute__((ext_vector_type(2)));
__device__ __forceinline__ unsigned cvt_pk_bf16(float lo, float hi) { f32x2 v = {lo, hi}; bf16x2_t b = __builtin_convertvector(v, bf16x2_t); return __builtin_bit_cast(unsigned, b); }
__device__ __forceinline__ float bf_lo(unsigned w) { return __builtin_bit_cast(float, w << 16); }
__device__ __forceinline__ float bf_hi(unsigned w) { return __builtin_bit_cast(float, w & 0xffff0000u); }
__device__ __forceinline__ float sigm(float x) { return __builtin_amdgcn_rcpf(1.f + __expf(-x)); }
__device__ __forceinline__ float silu(float x) { return x * sigm(x); }
__device__ __forceinline__ u32x4 pack8(const f32x4 a, const f32x4 b) { u32x4 w; w.x = cvt_pk_bf16(a[0], a[1]); w.y = cvt_pk_bf16(a[2], a[3]); w.z = cvt_pk_bf16(b[0], b[1]); w.w = cvt_pk_bf16(b[2], b[3]); return w; }
__device__ __forceinline__ void unpack8(const u32x4 w, f32x4& a, f32x4& b) { a = (f32x4){bf_lo(w.x), bf_hi(w.x), bf_lo(w.y), bf_hi(w.y)}; b = (f32x4){bf_lo(w.z), bf_hi(w.z), bf_lo(w.w), bf_hi(w.w)}; }

struct EpiBf16 {
    static constexpr bool PERM = true, AFTER_DRAIN = false;
    bf16_t* O; int ldc; int split_cols; size_t split_stride;
    __device__ __forceinline__ void operator()(const f32x4 (&acc)[2][2][4][2], const Unit& u, int wr, int wc, int fr, int fq) const {
        const int row0 = u.pm * BM + wr * 64 + fr; int colt = u.pn * BM; bf16_t* base = O;
        if (split_cols) { const int t = colt / split_cols; base += (size_t)t * split_stride; colt -= t * split_cols; }
        const int col0 = colt + wc * 32 + 8 * fq;
#pragma unroll
        for (int ai = 0; ai < 2; ++ai)
#pragma unroll
            for (int m = 0; m < 4; ++m) { bf16_t* rowp = base + (size_t)(row0 + ai * HALF + m * 16) * ldc + col0;
#pragma unroll
                for (int bj = 0; bj < 2; ++bj) *(u32x4*)(rowp + bj * HALF) = pack8(acc[ai][bj][m][0], acc[ai][bj][m][1]); }
    }
};
struct EpiC {
    static constexpr bool PERM = true, AFTER_DRAIN = false;
    bf16_t* OA; bf16_t* GA; const float* bias;
    __device__ __forceinline__ void operator()(const f32x4 (&acc)[2][2][4][2], const Unit& u, int wr, int wc, int fr, int fq) const {
        const int row0 = u.pm * BM + wr * 64 + fr;
        if (u.pn < 4) {
            const int col0 = u.pn * BM + wc * 32 + 8 * fq;
#pragma unroll
            for (int ai = 0; ai < 2; ++ai)
#pragma unroll
                for (int m = 0; m < 4; ++m) { bf16_t* rowp = OA + (size_t)(row0 + ai * HALF + m * 16) * 1024 + col0;
#pragma unroll
                    for (int bj = 0; bj < 2; ++bj) { f32x4 o0, o1; unpack8(*(const u32x4*)(rowp + bj * HALF), o0, o1); const f32x4 z0 = acc[ai][bj][m][0], z1 = acc[ai][bj][m][1];
#pragma unroll
                        for (int i = 0; i < 4; ++i) { o0[i] *= silu(z0[i]); o1[i] *= silu(z1[i]); }
                        *(u32x4*)(rowp + bj * HALF) = pack8(o0, o1); } asm volatile("" ::: "memory"); }
        } else {
            const int col0 = (u.pn - 4) * BM + wc * 32 + 8 * fq;
#pragma unroll
            for (int bj = 0; bj < 2; ++bj) { const f32x4 b0 = *(const f32x4*)(bias + col0 + bj * HALF), b1 = *(const f32x4*)(bias + col0 + bj * HALF + 4);
#pragma unroll
                for (int ai = 0; ai < 2; ++ai)
#pragma unroll
                    for (int m = 0; m < 4; ++m) { bf16_t* rowp = GA + (size_t)(row0 + ai * HALF + m * 16) * 1024 + col0 + bj * HALF; f32x4 g0 = acc[ai][bj][m][0] + b0, g1 = acc[ai][bj][m][1] + b1;
#pragma unroll
                        for (int i = 0; i < 4; ++i) { g0[i] = sigm(g0[i]); g1[i] = sigm(g1[i]); }
                        *(u32x4*)rowp = pack8(g0, g1); } }
        }
    }
};
struct EpiA {
    static constexpr bool PERM = true, AFTER_DRAIN = false;
    bf16_t* GLU; bf16_t* SZC; bf16_t* GC; const float* bias;
    __device__ __forceinline__ void operator()(const f32x4 (&acc)[2][2][4][2], const Unit& u, int wr, int wc, int fr, int fq) const {
        const int row0 = u.pm * BM + wr * 64 + fr;
        if (u.pn < 8) {
            const int col0 = u.pn * HALF + wc * 32 + 8 * fq;
#pragma unroll
            for (int ai = 0; ai < 2; ++ai)
#pragma unroll
                for (int m = 0; m < 4; ++m) { bf16_t* rowp = GLU + (size_t)(row0 + ai * HALF + m * 16) * 1024 + col0; f32x4 a0 = acc[ai][0][m][0], a1 = acc[ai][0][m][1]; const f32x4 b0 = acc[ai][1][m][0], b1 = acc[ai][1][m][1];
#pragma unroll
                    for (int i = 0; i < 4; ++i) { a0[i] *= sigm(b0[i]); a1[i] *= sigm(b1[i]); }
                    *(u32x4*)rowp = pack8(a0, a1); }
        } else if (u.pn < 12) {
            const int col0 = (u.pn - 8) * BM + wc * 32 + 8 * fq;
#pragma unroll
            for (int ai = 0; ai < 2; ++ai)
#pragma unroll
                for (int m = 0; m < 4; ++m) { bf16_t* rowp = SZC + (size_t)(row0 + ai * HALF + m * 16) * 1024 + col0;
#pragma unroll
                    for (int bj = 0; bj < 2; ++bj) { f32x4 z0 = acc[ai][bj][m][0], z1 = acc[ai][bj][m][1];
#pragma unroll
                        for (int i = 0; i < 4; ++i) { z0[i] = silu(z0[i]); z1[i] = silu(z1[i]); }
                        *(u32x4*)(rowp + bj * HALF) = pack8(z0, z1); } }
        } else {
            const int col0 = (u.pn - 12) * BM + wc * 32 + 8 * fq;
#pragma unroll
            for (int bj = 0; bj < 2; ++bj) { const f32x4 b0 = *(const f32x4*)(bias + col0 + bj * HALF), b1 = *(const f32x4*)(bias + col0 + bj * HALF + 4);
#pragma unroll
                for (int ai = 0; ai < 2; ++ai)
#pragma unroll
                    for (int m = 0; m < 4; ++m) { bf16_t* rowp = GC + (size_t)(row0 + ai * HALF + m * 16) * 1024 + col0 + bj * HALF; f32x4 g0 = acc[ai][bj][m][0] + b0, g1 = acc[ai][bj][m][1] + b1;
#pragma unroll
                        for (int i = 0; i < 4; ++i) { g0[i] = sigm(g0[i]); g1[i] = sigm(g1[i]); }
                        *(u32x4*)rowp = pack8(g0, g1); } }
        }
    }
};
template <bool ACCUM> struct EpiM {
    static constexpr bool PERM = true, AFTER_DRAIN = false;
    bf16_t* Mb; const bf16_t* G;
    __device__ __forceinline__ void operator()(const f32x4 (&acc)[2][2][4][2], const Unit& u, int wr, int wc, int fr, int fq) const {
        const int row0 = u.pm * BM + wr * 64 + fr, col0 = u.pn * BM + wc * 32 + 8 * fq;
#pragma unroll
        for (int ai = 0; ai < 2; ++ai)
#pragma unroll
            for (int m = 0; m < 4; ++m) { const size_t off = (size_t)(row0 + ai * HALF + m * 16) * 1024 + col0;
#pragma unroll
                for (int bj = 0; bj < 2; ++bj) { f32x4 g0, g1; unpack8(*(const u32x4*)(G + off + bj * HALF), g0, g1); f32x4 r0 = g0 * acc[ai][bj][m][0], r1 = g1 * acc[ai][bj][m][1];
                    if (ACCUM) { f32x4 p0, p1; unpack8(*(const u32x4*)(Mb + off + bj * HALF), p0, p1); r0 += p0; r1 += p1; }
                    *(u32x4*)(Mb + off + bj * HALF) = pack8(r0, r1); } asm volatile("" ::: "memory"); }
    }
};
struct EpiOut {
    static constexpr bool PERM = false, AFTER_DRAIN = false;
    const float* xres; float* out;
    __device__ __forceinline__ void operator()(const f32x4 (&acc)[2][2][4][2], const Unit& u, int wr, int wc, int fr, int fq) const {
        const int row0 = u.pm * BM + wr * 64 + fr, col0 = u.pn * BM + wc * 32 + 4 * fq;
#pragma unroll
        for (int ai = 0; ai < 2; ++ai)
#pragma unroll
            for (int m = 0; m < 4; ++m) { const size_t off = (size_t)(row0 + ai * HALF + m * 16) * 1024 + col0;
#pragma unroll
                for (int bj = 0; bj < 2; ++bj)
#pragma unroll
                    for (int n = 0; n < 2; ++n) { const f32x4 xr = *(const f32x4*)(xres + off + bj * HALF + n * 16); *(f32x4*)(out + off + bj * HALF + n * 16) = xr + acc[ai][bj][m][n]; } }
    }
};

template <class Epi, class Sched, bool ALIGN_EPI = false, bool SP2 = false>
__device__ __forceinline__ void gemm_phase(PG8_LAS unsigned char* lds, const Gemm g, const Sched& S, const Epi& E) {
    int tid_ = threadIdx.x; asm volatile("" : "+v"(tid_));
    const int tid = tid_, wid = __builtin_amdgcn_readfirstlane(tid >> 6), lane = tid & 63, wr = wid >> 2, wc = wid & 3, fr = lane & 15, fq = lane >> 4;
    const int K = g.K, nt = K / BK;
    unsigned voffA[2], voffB[2];
#pragma unroll
    for (int i = 0; i < 2; ++i) { int R, C; stage_rc(tid * 16 + i * 8192, R, C); const int Rb = Epi::PERM ? ((R & ~31) + perm32(R & 31)) : R;
        voffA[i] = (unsigned)(R * K + C) * 2u; voffB[i] = (unsigned)(Rb * K + C) * 2u; }
    const size_t kstep = (size_t)(BK * 2);
    const size_t hstep = (size_t)HALF * K * 2;
    const size_t tstep = 2 * hstep;
    const unsigned ldsw = (unsigned)wid * 1024u;
    const int aoff = lds_byte(wr * 64 + fr, fq * 8), boff = lds_byte(wc * 32 + fr, fq * 8);
#define PG8_SA(b, h) (((b) * 2 + (h)) * HTB)
#define PG8_SB(b, h) ((4 + (b) * 2 + (h)) * HTB)
#define PG8_STAGE(bufoff, gbase, voff) do { _Pragma("unroll") for (int _i = 0; _i < 2; ++_i) \
        __builtin_amdgcn_global_load_lds((const unsigned*)((const char*)(gbase) + (voff)[_i]), (PG8_LAS unsigned*)(lds + (bufoff) + ldsw + _i * 8192), 16, 0, 0); } while (0)
#define PG8_LDA(dst, b, h) do { _Pragma("unroll") for (int m = 0; m < 4; ++m) _Pragma("unroll") for (int k = 0; k < 2; ++k) dst[m][k] = *(const PG8_LAS bf16x8*)(lds + PG8_SA(b, h) + aoff + m * 2048 + k * 1024); } while (0)
#define PG8_LDB(dst, b, h) do { _Pragma("unroll") for (int n = 0; n < 2; ++n) _Pragma("unroll") for (int k = 0; k < 2; ++k) dst[n][k] = *(const PG8_LAS bf16x8*)(lds + PG8_SB(b, h) + boff + n * 2048 + k * 1024); } while (0)
#define PG8_MMA(ai, bj, At, Bt) do { __builtin_amdgcn_s_setprio(1); _Pragma("unroll") for (int m = 0; m < 4; ++m) _Pragma("unroll") for (int n = 0; n < 2; ++n) _Pragma("unroll") for (int k = 0; k < 2; ++k) \
        acc[ai][bj][m][n] = __builtin_amdgcn_mfma_f32_16x16x32_bf16(Bt[n][k], At[m][k], acc[ai][bj][m][n], 0, 0, 0); __builtin_amdgcn_s_setprio(0); } while (0)
#define PG8_WAIT_V(n) asm volatile("s_waitcnt vmcnt(" #n ")" ::: "memory")
#define PG8_WAIT_L(n) asm volatile("s_waitcnt lgkmcnt(" #n ")" ::: "memory")
#define PG8_BAR __builtin_amdgcn_s_barrier()
#define PG8_SCHED __builtin_amdgcn_sched_barrier(0)
    Unit cur, nxt; int ui = 0;
    if (!S.next(0, cur)) return;
    f32x4 acc[2][2][4][2];
#pragma unroll
    for (int a = 0; a < 2; ++a)
#pragma unroll
        for (int b = 0; b < 2; ++b)
#pragma unroll
            for (int m = 0; m < 4; ++m)
#pragma unroll
                for (int n = 0; n < 2; ++n) acc[a][b][m][n] = (f32x4){0.f, 0.f, 0.f, 0.f};
    bf16x8 At[4][2], B0[2][2], B1[2][2];
    const char* cA = (const char*)g.A + (size_t)cur.pm * tstep; const char* cB = (const char*)g.Bt + (size_t)cur.pn * tstep;
    S.a_ready(cur);
    if constexpr (SP2) {
        PG8_STAGE(PG8_SB(0, 0), cB, voffB); PG8_STAGE(PG8_SB(0, 1), cB + hstep, voffB); PG8_STAGE(PG8_SA(0, 0), cA, voffA); PG8_STAGE(PG8_SA(0, 1), cA + hstep, voffA);
        if (wr == 1) PG8_BAR;
        PG8_WAIT_V(2); PG8_BAR;
        PG8_STAGE(PG8_SB(1, 0), cB + kstep, voffB); PG8_STAGE(PG8_SA(1, 0), cA + kstep, voffA); PG8_STAGE(PG8_SB(1, 1), cB + hstep + kstep, voffB);
        PG8_WAIT_V(6); PG8_BAR;
    } else {
        PG8_STAGE(PG8_SB(0, 0), cB, voffB); PG8_STAGE(PG8_SA(0, 0), cA, voffA); PG8_STAGE(PG8_SB(0, 1), cB + hstep, voffB); PG8_STAGE(PG8_SA(0, 1), cA + hstep, voffA);
        if (wr == 1) PG8_BAR;
        PG8_WAIT_V(4); PG8_BAR;
        PG8_STAGE(PG8_SB(1, 0), cB + kstep, voffB); PG8_STAGE(PG8_SA(1, 0), cA + kstep, voffA); PG8_STAGE(PG8_SB(1, 1), cB + hstep + kstep, voffB);
        PG8_WAIT_V(6); PG8_BAR;
    }
    for (;;) {
        const bool has_next = S.next(ui + 1, nxt);
        const char* nA = has_next ? (const char*)g.A + (size_t)nxt.pm * tstep : cA; const char* nB = has_next ? (const char*)g.Bt + (size_t)nxt.pn * tstep : cB;
        for (int t = 0; t < nt; t += 2) {
            const bool last = (t == nt - 2);
            const char* a1 = cA + (size_t)(t + 1) * kstep;
            const char* a2 = last ? nA : cA + (size_t)(t + 2) * kstep; const char* b2 = last ? nB : cB + (size_t)(t + 2) * kstep;
            const char* a3 = a2 + kstep; const char* b3 = b2 + kstep;
            if (last && has_next) S.a_ready(nxt);
            if constexpr (SP2) {
            PG8_LDB(B0, 0, 0); PG8_LDB(B1, 0, 1); PG8_SCHED; PG8_LDA(At, 0, 0); PG8_STAGE(PG8_SA(1, 1), a1 + hstep, voffA);
            PG8_WAIT_V(8); PG8_WAIT_L(0); PG8_BAR; PG8_MMA(0, 0, At, B0); PG8_MMA(0, 1, At, B1); PG8_BAR; PG8_SCHED;
            PG8_LDA(At, 0, 1); PG8_STAGE(PG8_SB(0, 0), b2, voffB); PG8_STAGE(PG8_SB(0, 1), b2 + hstep, voffB); PG8_STAGE(PG8_SA(0, 0), a2, voffA);
            PG8_WAIT_V(8); PG8_WAIT_L(0); PG8_BAR; PG8_MMA(1, 0, At, B0); PG8_MMA(1, 1, At, B1); PG8_BAR; PG8_SCHED;
            PG8_LDB(B0, 1, 0); PG8_LDB(B1, 1, 1); PG8_SCHED; PG8_LDA(At, 1, 0); PG8_STAGE(PG8_SA(0, 1), a2 + hstep, voffA);
            PG8_WAIT_V(8); PG8_WAIT_L(0); PG8_BAR; PG8_MMA(0, 0, At, B0); PG8_MMA(0, 1, At, B1); PG8_BAR; PG8_SCHED;
            PG8_LDA(At, 1, 1); PG8_STAGE(PG8_SB(1, 0), b3, voffB); PG8_STAGE(PG8_SB(1, 1), b3 + hstep, voffB); PG8_STAGE(PG8_SA(1, 0), a3, voffA);
            PG8_WAIT_V(8); PG8_WAIT_L(0); PG8_BAR; PG8_MMA(1, 0, At, B0); PG8_MMA(1, 1, At, B1); PG8_BAR; PG8_SCHED;
            } else {
            PG8_LDB(B0, 0, 0); PG8_SCHED; PG8_LDA(At, 0, 0); PG8_STAGE(PG8_SA(1, 1), a1 + hstep, voffA);
            PG8_WAIT_L(8); PG8_BAR; PG8_WAIT_L(0); PG8_MMA(0, 0, At, B0); PG8_BAR; PG8_SCHED;
            PG8_LDB(B1, 0, 1); PG8_STAGE(PG8_SB(0, 0), b2, voffB);
            PG8_BAR; PG8_WAIT_L(0); PG8_MMA(0, 1, At, B1); PG8_BAR;
            PG8_LDA(At, 0, 1); PG8_STAGE(PG8_SA(0, 0), a2, voffA);
            PG8_BAR; PG8_WAIT_L(0); PG8_MMA(1, 0, At, B0); PG8_BAR; PG8_SCHED;
            PG8_STAGE(PG8_SB(0, 1), b2 + hstep, voffB);
            PG8_WAIT_V(6); PG8_BAR; PG8_MMA(1, 1, At, B1); PG8_BAR;
            PG8_LDB(B0, 1, 0); PG8_SCHED; PG8_LDA(At, 1, 0); PG8_STAGE(PG8_SA(0, 1), a2 + hstep, voffA);
            PG8_WAIT_L(8); PG8_BAR; PG8_WAIT_L(0); PG8_MMA(0, 0, At, B0); PG8_BAR; PG8_SCHED;
            PG8_LDB(B1, 1, 1); PG8_STAGE(PG8_SB(1, 0), b3, voffB);
            PG8_BAR; PG8_WAIT_L(0); PG8_MMA(0, 1, At, B1); PG8_BAR;
            PG8_LDA(At, 1, 1); PG8_STAGE(PG8_SA(1, 0), a3, voffA);
            PG8_BAR; PG8_WAIT_L(0); PG8_MMA(1, 0, At, B0); PG8_BAR; PG8_SCHED;
            PG8_STAGE(PG8_SB(1, 1), b3 + hstep, voffB);
            PG8_WAIT_V(6); PG8_BAR; PG8_MMA(1, 1, At, B1); PG8_BAR;
            }
        }
        if constexpr (ALIGN_EPI) { if (wr == 0) PG8_BAR; }
        if constexpr (!Epi::AFTER_DRAIN) { E(acc, cur, wr, wc, fr, fq); S.done(cur); }
        if (!has_next) break;
#pragma unroll
        for (int a = 0; a < 2; ++a)
#pragma unroll
            for (int b = 0; b < 2; ++b)
#pragma unroll
                for (int m = 0; m < 4; ++m)
#pragma unroll
                    for (int n = 0; n < 2; ++n) acc[a][b][m][n] = (f32x4){0.f, 0.f, 0.f, 0.f};
        cur = nxt; cA = nA; cB = nB; ++ui;
        if constexpr (ALIGN_EPI) { if (wr == 1) PG8_BAR; }
    }
    PG8_WAIT_V(0);
    if constexpr (!ALIGN_EPI) { if (wr == 0) PG8_BAR; }
    PG8_BAR;
    if constexpr (Epi::AFTER_DRAIN) { E.fused(acc, cur, wr, wc, fr, fq, lds, wid, lane); S.done(cur); }
#undef PG8_SA
#undef PG8_SB
#undef PG8_STAGE
#undef PG8_LDA
#undef PG8_LDB
#undef PG8_MMA
#undef PG8_WAIT_V
#undef PG8_WAIT_L
#undef PG8_BAR
#undef PG8_SCHED
}
}

#ifndef PG8_SP2
#define PG8_SP2 true
#endif
#ifndef PG8_ALIGN
#define PG8_ALIGN true
#endif
#ifndef MK_PER_PHASE
#define MK_PER_PHASE 0
#endif

constexpr int NWAVES = 8;
constexpr int BATCH = 2, SEQ = 8192, DM = 1024, DEPTH = 2, NH = 8, HD = 128, NBLK = 32, MOBA = 256, CK = 31;
constexpr int M = BATCH * SEQ;
constexpr int N_IN = 9216;
constexpr float EPS = 1e-6f;
constexpr float QSCALE = 0.08838834764831845f * 1.4426950408889634f;
constexpr int NPHASE_L = 10, NPHASES = NPHASE_L * DEPTH;

constexpr size_t MiB = 1u << 20;
constexpr size_t WS_CTL = 0, CTL_ZERO_BYTES = 65536;
constexpr size_t WS_ROPE = 1 * MiB;
constexpr size_t WS_KMEAN = 2 * MiB;
constexpr size_t WS_LPART = 2 * MiB + 512 * 1024;
constexpr size_t WS_WT = 4 * MiB;
constexpr size_t WT_B = 0, WT_C = 3072, WT_A = 5120, WT_PA = 9216, WT_PC = 10240, WT_O = 11264, WT_ROWS = 12288;
constexpr size_t WS_XN = 28 * MiB;
constexpr size_t WS_Q = 60 * MiB, WS_K = 92 * MiB, WS_V = 124 * MiB;
constexpr size_t WS_LIST = 156 * MiB;
constexpr size_t WS_PART = 172 * MiB;
constexpr size_t WS_GA = 92 * MiB, WS_GLU = 124 * MiB, WS_SZC = 156 * MiB, WS_GC = 188 * MiB, WS_C = 220 * MiB, WS_MB = 252 * MiB, WS_END = 284 * MiB;
constexpr int CW_BAR = 1024;
constexpr int CW_CNT = 8192;
static_assert((CW_CNT + DEPTH * 512) * 4 <= (int)CTL_ZERO_BYTES && CW_BAR + 3456 <= CW_CNT, "CTL map");

constexpr int RING_OFF = 0, RING_BYTES = 131072;
constexpr int LDSCTL_OFF = RING_BYTES, MISC_OFF = LDSCTL_OFF + 320;
constexpr int XTRA_OFF = RING_BYTES + 512;
constexpr int LDS_BYTES = 147456;
#define GAS __attribute__((address_space(1)))
#define LAS __attribute__((address_space(3)))
typedef unsigned short bf16;
typedef unsigned v4u __attribute__((ext_vector_type(4)));
typedef float f32x4 __attribute__((ext_vector_type(4)));
typedef short bf16x8 __attribute__((ext_vector_type(8)));
typedef GAS unsigned gu32;
typedef GAS unsigned long long gu64;
#define RLX_AGENT __ATOMIC_RELAXED, __HIP_MEMORY_SCOPE_AGENT
#define LDS_WAIT() asm volatile("s_waitcnt lgkmcnt(0)" ::: "memory")
#define VM_WAIT() asm volatile("s_waitcnt vmcnt(0)" ::: "memory")
__device__ __forceinline__ unsigned long long rt() { return __builtin_amdgcn_s_memrealtime(); }
__device__ __forceinline__ unsigned f2bf(float f) { unsigned u = __builtin_bit_cast(unsigned, f); return (u + 0x7fffu + ((u >> 16) & 1u)) >> 16; }
__device__ __forceinline__ unsigned pk2(float lo, float hi) { return f2bf(lo) | (f2bf(hi) << 16); }

#define XB_TMO      128
#define XB_XCNT(j)  (256  + 64 * (j))
#define XB_XSUB(j)  (1280 + 64 * (j))
#define XB_XGEN(j)  (2304 + 64 * (j))
#define XB_TOP      3328
#define XB_TOPGEN   3392
#define XCD_BAR_WORDS 3456
#define XB_SPIN_CAP (1u << 18)

__device__ __forceinline__ unsigned xb_ld(unsigned* p)              { return __hip_atomic_load(p, __ATOMIC_RELAXED, __HIP_MEMORY_SCOPE_AGENT); }
__device__ __forceinline__ unsigned xb_add(unsigned* p, unsigned v) { return __hip_atomic_fetch_add(p, v, __ATOMIC_RELAXED, __HIP_MEMORY_SCOPE_AGENT); }
__device__ __forceinline__ unsigned xb_xcc_id() { return (unsigned)__builtin_amdgcn_s_getreg((3 << 11) | 20) & 0xFu; }
#define XB_SPIN(cond, bar) do { unsigned _sp = 0; while (cond) { __builtin_amdgcn_s_sleep(1); \
    if ((++_sp & 255u) == 0u) { if (xb_ld(&(bar)[XB_TMO])) break; if (_sp > XB_SPIN_CAP) { atomicAdd(&(bar)[XB_TMO], 1u); break; } } } } while (0)

struct XcdBarrier {
    unsigned* bar; unsigned x;
    volatile LAS unsigned* st;
};

__device__ __forceinline__ XcdBarrier xcd_barrier_post(unsigned* bar, volatile LAS unsigned* st) {
    XcdBarrier b; b.bar = bar; b.x = xb_xcc_id(); b.st = st;
    if (threadIdx.x == 0) (void)xb_add(&bar[XB_XCNT(b.x)], 1u);
    return b;
}
__device__ __forceinline__ void xcd_barrier_complete(unsigned* bar, unsigned x, unsigned& nloc, unsigned& nx) {
    const unsigned G = gridDim.x * gridDim.y * gridDim.z;
    unsigned sum, cnt, mine, sp = 0u;
    for (;;) {
        sum = 0u; cnt = 0u; mine = 0u;
#pragma unroll
        for (unsigned j = 0; j < 16; ++j) { const unsigned c = xb_ld(&bar[XB_XCNT(j)]); sum += c; cnt += (c > 0u) ? 1u : 0u; mine = (j == x) ? c : mine; }
        if (sum == G) break;
        __builtin_amdgcn_s_sleep(1);
        if ((++sp & 255u) == 0u) { if (xb_ld(&bar[XB_TMO])) break; if (sp > XB_SPIN_CAP) { atomicAdd(&bar[XB_TMO], 1u); break; } }
    }
    nloc = mine > 0u ? mine : 1u; nx = cnt > 0u ? cnt : 1u;
}

__device__ __forceinline__ void xcd_barrier(const XcdBarrier& b) {
    asm volatile("s_waitcnt vmcnt(0)" ::: "memory");
    __syncthreads();
    if (threadIdx.x == 0) {
        unsigned* bar = b.bar; unsigned bx_ = b.x;
        asm volatile("" : "+s"(bar), "+s"(bx_));
        __builtin_amdgcn_s_waitcnt(0);
        unsigned nloc = b.st[0], nx = b.st[1];
        if (nloc == 0u) { xcd_barrier_complete(bar, bx_, nloc, nx); b.st[0] = nloc; b.st[1] = nx; }
        const unsigned old = xb_add(&bar[XB_XSUB(bx_)], 1u);
        const unsigned gen = old / nloc;
        if (old + 1u == (gen + 1u) * nloc) {
            __builtin_amdgcn_fence(__ATOMIC_RELEASE, "agent");
            asm volatile("s_waitcnt vmcnt(0)" ::: "memory");
            const unsigned og = xb_add(&bar[XB_TOP], 1u);
            const unsigned tg = og / nx;
            if (og + 1u == (tg + 1u) * nx) xb_add(&bar[XB_TOPGEN], 1u);
            else XB_SPIN(xb_ld(&bar[XB_TOPGEN]) == tg, bar);
            __builtin_amdgcn_fence(__ATOMIC_ACQUIRE, "agent");
            xb_add(&bar[XB_XGEN(bx_)], 1u);
            asm volatile("s_waitcnt vmcnt(0)" ::: "memory");
        } else {
            XB_SPIN(xb_ld(&bar[XB_XGEN(bx_)]) == gen, bar);
            __builtin_amdgcn_fence(__ATOMIC_ACQUIRE, "agent");
            asm volatile("s_waitcnt vmcnt(0)" ::: "memory");
        }
    }
    __syncthreads();
}

typedef float f32x16 __attribute__((ext_vector_type(16)));
typedef short v4i16_t __attribute__((ext_vector_type(4)));
typedef float f32x2v __attribute__((ext_vector_type(2)));
struct Frame {
    LAS unsigned char* lds;
    volatile LAS unsigned* MISC;
    gu32* ctl;
    int tid, lane, wave;
    int vcu, G;
    unsigned char* ws;
};
struct Args { const float* in[13]; float* out; unsigned char* ws; int ph_lo, ph_hi; };
#define KARG ((const volatile __attribute__((address_space(4))) Args*)__builtin_amdgcn_kernarg_segment_ptr())
#define ARG_IN(i) ((const float*)KARG->in[i])
#define ARG_OUT ((float*)KARG->out)
__device__ __forceinline__ float wave_sum(float v) {
#pragma unroll
    for (int o = 1; o < 64; o <<= 1) v += __shfl_xor(v, o);
    return v;
}
__device__ __forceinline__ float wave_max(float v) {
#pragma unroll
    for (int o = 1; o < 64; o <<= 1) v = fmaxf(v, __shfl_xor(v, o));
    return v;
}
using pg8::cvt_pk_bf16; using pg8::bf_lo; using pg8::bf_hi; using pg8::sigm; using pg8::silu;

__device__ __forceinline__ void p0_transpose_item(const float* W, int ldw, int src_col0, bf16* WT, int dst_row0, int k0, LAS float* scr, int lane) {
#pragma unroll 8
    for (int i = 0; i < 32; ++i) { const int kk = 2 * i + (lane >> 5); scr[kk * 33 + (lane & 31)] = W[(size_t)(k0 + kk) * ldw + src_col0 + (lane & 31)]; }
    LDS_WAIT(); asm volatile("" ::: "memory");
    const int c = lane & 7;
#pragma unroll
    for (int j = 0; j < 4; ++j) { const int n = (lane >> 3) + 8 * j; const LAS float* s = scr + (8 * c) * 33 + n;
        v4u o; o.x = pk2(s[0 * 33], s[1 * 33]); o.y = pk2(s[2 * 33], s[3 * 33]); o.z = pk2(s[4 * 33], s[5 * 33]); o.w = pk2(s[6 * 33], s[7 * 33]);
        *(GAS v4u*)(WT + (size_t)(dst_row0 + n) * DM + k0 + 8 * c) = o; }
    LDS_WAIT(); asm volatile("" ::: "memory");
}
__device__ __forceinline__ void ph0_prologue(Frame& F, int l, const float* xin) {
    LAS float* scr = (LAS float*)(F.lds + RING_OFF + F.wave * 16384);
    const int gw = F.vcu * NWAVES + F.wave, NGW = F.G * NWAVES;
    bf16* WT = (bf16*)(F.ws + WS_WT);
    const float* w_in = ARG_IN(2) + (size_t)l * DM * N_IN;
    const float* w_pa = ARG_IN(10) + (size_t)l * DM * DM; const float* w_pc = ARG_IN(11) + (size_t)l * DM * DM; const float* w_o = ARG_IN(12) + (size_t)l * DM * DM;
    constexpr int NRB = WT_ROWS / 32, NITEMS = NRB * (DM / 64);
    for (int it = gw; it < NITEMS; it += NGW) {
        const int rb = it % NRB, kb = it / NRB, r = rb * 32;
        const float* W; int ldw, src;
        if (r < (int)WT_C) { W = w_in; ldw = N_IN; src = r; }
        else if (r < (int)WT_A) { const int q = r - (int)WT_C; W = w_in; ldw = N_IN; src = q < 1024 ? 3072 + q : 7168 + (q - 1024); }
        else if (r < (int)WT_PA) { const int q = r - (int)WT_A; W = w_in; ldw = N_IN;
            if (q < 2048) { const int pn = q >> 8, bj = (q >> 7) & 1, i = q & 127; src = 4096 + 1024 * bj + 128 * pn + i; }
            else if (q < 3072) src = 6144 + (q - 2048);
            else src = 8192 + (q - 3072); }
        else if (r < (int)WT_PC) { W = w_pa; ldw = DM; src = r - (int)WT_PA; }
        else if (r < (int)WT_O) { W = w_pc; ldw = DM; src = r - (int)WT_PC; }
        else { W = w_o; ldw = DM; src = r - (int)WT_O; }
        p0_transpose_item(W, ldw, src, WT, r, kb * 64, scr, F.lane);
    }
    const float* g = ARG_IN(1) + (size_t)l * DM; bf16* XN = (bf16*)(F.ws + WS_XN);
    f32x4 gv[4];
#pragma unroll
    for (int j = 0; j < 4; ++j) gv[j] = ((const GAS f32x4*)g)[F.lane + 64 * j];
    for (int m = gw; m < M; m += NGW) {
        const GAS f32x4* xr = (const GAS f32x4*)(xin + (size_t)m * DM) + F.lane;
        f32x4 v[4]; float s = 0.f;
#pragma unroll
        for (int j = 0; j < 4; ++j) { v[j] = xr[64 * j]; s += (v[j].x * v[j].x + v[j].y * v[j].y) + (v[j].z * v[j].z + v[j].w * v[j].w); }
        const float rstd = 1.f / sqrtf(wave_sum(s) * (1.f / DM) + EPS);
        GAS unsigned long long* o8 = (GAS unsigned long long*)(XN + (size_t)m * DM) + F.lane;
#pragma unroll
        for (int j = 0; j < 4; ++j) { const f32x4 y = v[j] * rstd * gv[j]; o8[64 * j] = (unsigned long long)cvt_pk_bf16(y.x, y.y) | ((unsigned long long)cvt_pk_bf16(y.z, y.w) << 32); }
    }
    if (blockIdx.x == 0) { gu32* cnt = F.ctl + CW_CNT + l * 512; cnt[F.tid] = 0u; }
    if (l == 0) {
        float* ct = (float*)(F.ws + WS_ROPE); float* st = ct + SEQ * 16;
        constexpr float IF[16] = {1.000000000e+00f, 4.403665960e-01f, 1.939227432e-01f, 8.539710194e-02f, 3.760603070e-02f, 1.656044088e-02f, 7.292664610e-03f, 3.211446106e-03f,
                                  1.414213562e-03f, 6.227724371e-04f, 2.742481884e-04f, 1.207697351e-04f, 5.318295734e-05f, 2.341999971e-05f, 1.031338525e-05f, 4.541670478e-06f};
        for (int t = (F.vcu * NWAVES + F.wave) * 64 + F.lane; t < SEQ; t += NGW * 64) {
#pragma unroll
            for (int i = 0; i < 16; ++i) { float sn, cs; sincosf((float)t * IF[i], &sn, &cs); ct[t * 16 + i] = cs; st[t * 16 + i] = sn; }
        }
    }
}

__device__ __forceinline__ void ph2_qknorm(Frame& F, int l) {
    const float* ct = (const float*)(F.ws + WS_ROPE); const float* st = ct + SEQ * 16;
    float* kmean = (float*)(F.ws + WS_KMEAN);
    LAS float* red = (LAS float*)(F.lds + RING_OFF);
    const int lane = F.lane;
    for (int it = F.vcu; it < 2 * BATCH * NBLK * NH; it += F.G) {
        const int which = it & 1, h = (it >> 1) & 7, n = (it >> 4) & 31, b = it >> 9;
        bf16* buf = (bf16*)(F.ws + (which ? WS_K : WS_Q));
        const float* g = (which ? ARG_IN(5) : ARG_IN(4)) + (size_t)l * HD;
        const float g0 = g[2 * lane], g1 = g[2 * lane + 1];
        const float osc = which ? 1.f : QSCALE;
        float s0 = 0.f, s1 = 0.f;
        for (int rr = 0; rr < 32; ++rr) {
            const int t = n * MOBA + F.wave * 32 + rr; const size_t row = (size_t)b * SEQ + t;
            GAS unsigned* p = (GAS unsigned*)(buf + row * DM + h * HD) + lane;
            const unsigned w = *p; const float x0 = bf_lo(w), x1 = bf_hi(w);
            const float ss = wave_sum(x0 * x0 + x1 * x1);
            const float rstd = 1.f / sqrtf(ss * (1.f / HD) + EPS);
            float y0 = x0 * rstd * g0, y1 = x1 * rstd * g1;
            const float p0 = __shfl_xor(y0, 8), p1 = __shfl_xor(y1, 8);
            if (lane < 16) { const int i = 2 * (lane & 7); const float c0 = ct[t * 16 + i], c1 = ct[t * 16 + i + 1], sn0 = st[t * 16 + i], sn1 = st[t * 16 + i + 1];
                if (lane < 8) { y0 = y0 * c0 - p0 * sn0; y1 = y1 * c1 - p1 * sn1; } else { y0 = y0 * c0 + p0 * sn0; y1 = y1 * c1 + p1 * sn1; } }
            s0 += y0; s1 += y1;
            *p = cvt_pk_bf16(y0 * osc, y1 * osc);
        }
        if (which) {
            red[F.wave * 128 + 2 * lane] = s0; red[F.wave * 128 + 2 * lane + 1] = s1;
            __syncthreads();
            if (F.tid < 128) { float s = 0.f;
#pragma unroll
                for (int w = 0; w < 8; ++w) s += red[w * 128 + F.tid];
                kmean[(size_t)((b * NH + h) * NBLK + n) * HD + F.tid] = s * (1.f / MOBA); }
            __syncthreads();
        }
    }
}

__device__ __forceinline__ void ph3_gate(Frame& F, int l) {
    const float* kmean = (const float*)(F.ws + WS_KMEAN);
    const bf16* Q = (const bf16*)(F.ws + WS_Q);
    gu32* cnt = F.ctl + CW_CNT + l * 512; unsigned* list = (unsigned*)(F.ws + WS_LIST);
    LAS float* km = (LAS float*)(F.lds + RING_OFF);
    for (int it = F.vcu; it < BATCH * NH * 16; it += F.G) {
        const int tc = it & 15, bh = it >> 4, b = bh >> 3, h = bh & 7;
        __syncthreads();
        for (int e = F.tid; e < NBLK * HD; e += NWAVES * 64) km[e] = kmean[(size_t)bh * NBLK * HD + e];
        __syncthreads();
        const int t = tc * 512 + F.tid, bq = t >> 8;
        if (bq == 0) continue;
        const bf16* qrow = Q + ((size_t)b * SEQ + t) * DM + h * HD;
        float sc[NBLK];
#pragma unroll
        for (int n = 0; n < NBLK; ++n) sc[n] = 0.f;
        for (int c = 0; c < 16; ++c) {
            const v4u qw = *(const GAS v4u*)(qrow + 8 * c);
            const float q0 = bf_lo(qw.x), q1 = bf_hi(qw.x), q2 = bf_lo(qw.y), q3 = bf_hi(qw.y), q4 = bf_lo(qw.z), q5 = bf_hi(qw.z), q6 = bf_lo(qw.w), q7 = bf_hi(qw.w);
#pragma unroll
            for (int n = 0; n < NBLK - 1; ++n) if (n < bq) {
                const f32x4 k0 = *(const LAS f32x4*)(km + n * HD + 8 * c), k1 = *(const LAS f32x4*)(km + n * HD + 8 * c + 4);
                sc[n] += (q0 * k0.x + q1 * k0.y) + (q2 * k0.z + q3 * k0.w) + (q4 * k1.x + q5 * k1.y) + (q6 * k1.z + q7 * k1.w);
            }
        }
        const int nv = bq < 3 ? bq : 3;
#pragma unroll
        for (int rk = 0; rk < 3; ++rk) if (rk < nv) {
            float best = -INFINITY; int bi = 0;
#pragma unroll
            for (int n = 0; n < NBLK - 1; ++n) if (n < bq && sc[n] > best) { best = sc[n]; bi = n; }
#pragma unroll
            for (int n = 0; n < NBLK - 1; ++n) if (n == bi) sc[n] = -INFINITY;
            const unsigned pos = __hip_atomic_fetch_add(cnt + bh * NBLK + bi, 1u, RLX_AGENT);
            list[(size_t)(bh * NBLK + bi) * SEQ + pos] = (unsigned)t | ((unsigned)rk << 13);
        }
    }
}

__device__ __forceinline__ int koff(int r, int c) { return r * 256 + ((c ^ (r & 15)) << 4); }
__device__ __forceinline__ int voff(int r, int c) { return r * 256 + ((((c >> 2) ^ (r & 3)) << 6) | ((c & 3) << 4)); }
__device__ __forceinline__ void load_kv_block(Frame& F, const bf16* K, const bf16* V, size_t row0, int h) {
    LAS unsigned char* lk = F.lds + RING_OFF; LAS unsigned char* lv = lk + 65536;
#pragma unroll
    for (int half = 0; half < 2; ++half) {
        v4u kr[4], vr[4];
#pragma unroll
        for (int p = 0; p < 4; ++p) { const int idx = (half * 4 + p) * 512 + F.tid, r = idx >> 4, c = idx & 15;
            kr[p] = *(const GAS v4u*)(K + (row0 + r) * DM + h * HD + 8 * c); vr[p] = *(const GAS v4u*)(V + (row0 + r) * DM + h * HD + 8 * c); }
#pragma unroll
        for (int p = 0; p < 4; ++p) { const int idx = (half * 4 + p) * 512 + F.tid, r = idx >> 4, c = idx & 15;
            *(LAS v4u*)(lk + koff(r, c)) = kr[p]; *(LAS v4u*)(lv + voff(r, c)) = vr[p]; }
    }
}
template <bool DIAG>
__device__ __forceinline__ void attn_core(LAS unsigned char* lds, const bf16x8 (&qf)[8], int ntiles, float B2, f32x16 (&o)[4], float& ls, int lane) {
    const int r32 = lane & 31, hh = lane >> 5;
    const int kbase = r32 * 256, kx = r32 & 15;
    const int q_ = (lane & 15) >> 2, p_ = lane & 3, g1 = (lane >> 4) & 1;
    int vb[4];
#pragma unroll
    for (int d = 0; d < 4; ++d) vb[d] = 65536 + (4 * hh + q_) * 256 + ((d ^ q_) << 6) + 32 * g1 + 8 * p_;
    for (int kt = 0; kt < ntiles; ++kt) {
        f32x16 p = {0.f, 0.f, 0.f, 0.f, 0.f, 0.f, 0.f, 0.f, 0.f, 0.f, 0.f, 0.f, 0.f, 0.f, 0.f, 0.f};
        const LAS unsigned char* kp = lds + kt * 8192 + kbase;
#pragma unroll
        for (int ds = 0; ds < 8; ++ds) { const bf16x8 kf = *(const LAS bf16x8*)(kp + (((2 * ds + hh) ^ kx) << 4)); p = __builtin_amdgcn_mfma_f32_32x32x16_bf16(kf, qf[ds], p, 0, 0, 0); }
        const bool dg = DIAG && (kt == ntiles - 1);
#pragma unroll
        for (int r = 0; r < 16; ++r) { float e = __builtin_amdgcn_exp2f(p[r] - B2); if (dg && ((r & 3) + 8 * (r >> 2) + 4 * hh) > r32) e = 0.f; p[r] = e; ls += e; }
        v4u pw0, pw1;
        pw0.x = cvt_pk_bf16(p[0], p[1]); pw0.y = cvt_pk_bf16(p[2], p[3]); pw0.z = cvt_pk_bf16(p[4], p[5]); pw0.w = cvt_pk_bf16(p[6], p[7]);
        pw1.x = cvt_pk_bf16(p[8], p[9]); pw1.y = cvt_pk_bf16(p[10], p[11]); pw1.z = cvt_pk_bf16(p[12], p[13]); pw1.w = cvt_pk_bf16(p[14], p[15]);
        const bf16x8 pa0 = __builtin_bit_cast(bf16x8, pw0), pa1 = __builtin_bit_cast(bf16x8, pw1);
#pragma unroll
        for (int d = 0; d < 4; ++d) {
#pragma unroll
            for (int s = 0; s < 2; ++s) {
                const LAS unsigned char* vp = lds + vb[d] + kt * 8192 + s * 4096;
                const v4i16_t lo = __builtin_amdgcn_ds_read_tr16_b64_v4i16((LAS v4i16_t*)vp);
                const v4i16_t hi = __builtin_amdgcn_ds_read_tr16_b64_v4i16((LAS v4i16_t*)(vp + 2048));
                const bf16x8 vf = (bf16x8){lo[0], lo[1], lo[2], lo[3], hi[0], hi[1], hi[2], hi[3]};
                o[d] = __builtin_amdgcn_mfma_f32_32x32x16_bf16(s ? pa1 : pa0, vf, o[d], 0, 0, 0);
            }
        }
    }
}
__device__ __forceinline__ float softmax_shift(Frame& F, int l) {
    const float* gq = ARG_IN(4) + (size_t)l * HD; const float* gk = ARG_IN(5) + (size_t)l * HD;
    const float mq = wave_max(fmaxf(fabsf(gq[2 * F.lane]), fabsf(gq[2 * F.lane + 1]))), mk = wave_max(fmaxf(fabsf(gk[2 * F.lane]), fabsf(gk[2 * F.lane + 1])));
    return 1.4426950408889634f * 11.313708498984761f * mq * mk;
}

__device__ __forceinline__ void ph4_sparse(Frame& F, int l) {
    const bf16* Q = (const bf16*)(F.ws + WS_Q); const bf16* K = (const bf16*)(F.ws + WS_K); const bf16* V = (const bf16*)(F.ws + WS_V);
    bf16* PART = (bf16*)(F.ws + WS_PART); float* LP = (float*)(F.ws + WS_LPART);
    const unsigned* list = (const unsigned*)(F.ws + WS_LIST); gu32* cnt = F.ctl + CW_CNT + l * 512;
    LAS int* pre = (LAS int*)(F.lds + XTRA_OFF);
    LAS unsigned* ent = (LAS unsigned*)(F.lds + XTRA_OFF + 4096);
    const float B2 = softmax_shift(F, l);
    const int lane = F.lane, r32 = lane & 31, hh = lane >> 5;
    const int myc = (int)__hip_atomic_load(cnt + F.tid, RLX_AGENT);
    { int v = (myc + 255) >> 8; pre[F.tid] = v; __syncthreads();
      for (int off = 1; off < 512; off <<= 1) { const int a = (F.tid >= off) ? pre[F.tid - off] : 0; __syncthreads(); v += a; pre[F.tid] = v; __syncthreads(); } }
    const int T = pre[511];
    const int lo = (int)(((long)F.vcu * T) / F.G), hi = (int)(((long)(F.vcu + 1) * T) / F.G);
    int cur = -1;
    for (int it = lo; it < hi; ++it) {
        int a = 0, bnd = 511;
        while (a < bnd) { const int mid = (a + bnd) >> 1; if (pre[mid] > it) bnd = mid; else a = mid + 1; }
        const int bhn = a, chunk = it - (bhn ? pre[bhn - 1] : 0), bh = bhn >> 5, n = bhn & 31, b = bh >> 3, h = bh & 7;
        const int c_tot = (int)__hip_atomic_load(cnt + bhn, RLX_AGENT);
        __syncthreads();
        if (bhn != cur) { load_kv_block(F, K, V, (size_t)b * SEQ + n * MOBA, h); cur = bhn; }
        if (F.tid < 256) { const int idx = chunk * 256 + F.tid; ent[F.tid] = idx < c_tot ? list[(size_t)bhn * SEQ + idx] : 0xffffffffu; }
        __syncthreads();
        const unsigned e = ent[F.wave * 32 + r32];
        const bool valid = e != 0xffffffffu;
        const size_t qrow = (size_t)b * SEQ + (valid ? (e & 8191u) : 0u);
        bf16x8 qf[8];
#pragma unroll
        for (int ds = 0; ds < 8; ++ds) qf[ds] = *(const GAS bf16x8*)(Q + qrow * DM + h * HD + 16 * ds + 8 * hh);
        f32x16 o[4];
#pragma unroll
        for (int d = 0; d < 4; ++d)
#pragma unroll
            for (int r = 0; r < 16; ++r) o[d][r] = 0.f;
        float ls = 0.f;
        if (__any(valid)) {
            attn_core<false>(F.lds + RING_OFF, qf, 8, B2, o, ls, lane);
            ls += __shfl_xor(ls, 32);
            if (valid && hh == 0) LP[((size_t)(e >> 13) * M + qrow) * NH + h] = ls;
#pragma unroll
            for (int r = 0; r < 16; ++r) {
                const unsigned eq = ent[F.wave * 32 + (r & 3) + 8 * (r >> 2) + 4 * hh];
                if (eq != 0xffffffffu) { bf16* dst = PART + ((size_t)(eq >> 13) * M + (size_t)b * SEQ + (eq & 8191u)) * DM + h * HD + r32;
#pragma unroll
                    for (int d = 0; d < 4; ++d) dst[32 * d] = (bf16)(cvt_pk_bf16(o[d][r], 0.f) & 0xffffu); }
            }
        }
    }
}

__device__ __forceinline__ void ph5_diag(Frame& F, int l) {
    bf16* Q = (bf16*)(F.ws + WS_Q); const bf16* K = (const bf16*)(F.ws + WS_K); const bf16* V = (const bf16*)(F.ws + WS_V);
    const bf16* PART = (const bf16*)(F.ws + WS_PART); const float* LP = (const float*)(F.ws + WS_LPART);
    LAS float* lsh = (LAS float*)(F.lds + XTRA_OFF);
    const float B2 = softmax_shift(F, l);
    const int lane = F.lane, r32 = lane & 31, hh = lane >> 5;
    for (int it = F.vcu; it < BATCH * NH * NBLK; it += F.G) {
        const int bq = it & 31, bh = it >> 5, b = bh >> 3, h = bh & 7;
        const size_t row0 = (size_t)b * SEQ + bq * MOBA;
        __syncthreads();
        load_kv_block(F, K, V, row0, h);
        __syncthreads();
        const size_t qrow = row0 + F.wave * 32 + r32;
        bf16x8 qf[8];
#pragma unroll
        for (int ds = 0; ds < 8; ++ds) qf[ds] = *(const GAS bf16x8*)(Q + qrow * DM + h * HD + 16 * ds + 8 * hh);
        f32x16 o[4];
#pragma unroll
        for (int d = 0; d < 4; ++d)
#pragma unroll
            for (int r = 0; r < 16; ++r) o[d][r] = 0.f;
        float ls = 0.f;
        attn_core<true>(F.lds + RING_OFF, qf, F.wave + 1, B2, o, ls, lane);
        ls += __shfl_xor(ls, 32);
        const int nv = bq < 3 ? bq : 3;
        for (int j = 0; j < nv; ++j) ls += LP[((size_t)j * M + qrow) * NH + h];
        if (hh == 0) lsh[F.wave * 32 + r32] = 1.f / ls;
        LDS_WAIT(); asm volatile("" ::: "memory");
#pragma unroll
        for (int r = 0; r < 16; ++r) {
            const int ql = (r & 3) + 8 * (r >> 2) + 4 * hh; const size_t rw = row0 + F.wave * 32 + ql;
            float acc[4];
#pragma unroll
            for (int d = 0; d < 4; ++d) acc[d] = o[d][r];
            for (int j = 0; j < nv; ++j) { const bf16* src = PART + ((size_t)j * M + rw) * DM + h * HD + r32;
#pragma unroll
                for (int d = 0; d < 4; ++d) acc[d] += bf_lo((unsigned)src[32 * d]); }
            const float inv = lsh[F.wave * 32 + ql];
            bf16* dst = Q + rw * DM + h * HD + r32;
#pragma unroll
            for (int d = 0; d < 4; ++d) dst[32 * d] = (bf16)(cvt_pk_bf16(acc[d] * inv, 0.f) & 0xffffu);
        }
    }
}

__device__ __forceinline__ void ph7_conv(Frame& F, int l) {
    const bf16* GLU = (const bf16*)(F.ws + WS_GLU); const bf16* SZC = (const bf16*)(F.ws + WS_SZC); bf16* C = (bf16*)(F.ws + WS_C);
    const float* cw = ARG_IN(6) + (size_t)l * CK * DM; const float* cb = ARG_IN(7) + (size_t)l * DM; const float* cg = ARG_IN(8) + (size_t)l * DM; const float* cbeta = ARG_IN(9) + (size_t)l * DM;
    LAS unsigned* tile = (LAS unsigned*)(F.lds + RING_OFF);
    LAS float* red = (LAS float*)(F.lds + XTRA_OFF);
    LAS float* stat = red + 512;
    const int tid = F.tid, lane = F.lane;
    constexpr int TT = 8;
    float w0[CK], w1[CK];
#pragma unroll
    for (int j = 0; j < CK; ++j) { const f32x2v wv = *(const GAS f32x2v*)(cw + (size_t)j * DM + 2 * tid); w0[j] = wv.x; w1[j] = wv.y; }
    const f32x2v bv = *(const GAS f32x2v*)(cb + 2 * tid), gv = *(const GAS f32x2v*)(cg + 2 * tid), bev = *(const GAS f32x2v*)(cbeta + 2 * tid);
    for (int it = F.vcu; it < M / 32; it += F.G) {
        const int tok0 = it * 32, t0 = tok0 & (SEQ - 1);
        __syncthreads();
        for (int idx = tid; idx < 62 * 128; idx += NWAVES * 64) { const int i = idx >> 7, c = idx & 127, t = t0 - 30 + i;
            v4u v = {0u, 0u, 0u, 0u}; if (t >= 0) v = *(const GAS v4u*)(GLU + (size_t)(tok0 - 30 + i) * DM + 8 * c);
            *(LAS v4u*)(tile + i * 512 + 4 * c) = v; }
        __syncthreads();
#pragma unroll 1
        for (int hf = 0; hf < 32 / TT; ++hf) {
            float a0[TT], a1[TT];
#pragma unroll
            for (int tt = 0; tt < TT; ++tt) { a0[tt] = bv.x; a1[tt] = bv.y; }
#pragma unroll
            for (int i = 0; i < TT + 30; ++i) { const unsigned w = tile[(hf * TT + i) * 512 + tid]; const float x0 = bf_lo(w), x1 = bf_hi(w);
#pragma unroll
                for (int tt = 0; tt < TT; ++tt) if (i - tt >= 0 && i - tt < CK) { a0[tt] += w0[i - tt] * x0; a1[tt] += w1[i - tt] * x1; } }
            float rv[2 * TT];
#pragma unroll
            for (int tt = 0; tt < TT; ++tt) { rv[2 * tt] = a0[tt] + a1[tt]; rv[2 * tt + 1] = a0[tt] * a0[tt] + a1[tt] * a1[tt]; }
#pragma unroll
            for (int m = TT; m >= 1; m >>= 1) {
                const bool up = (lane & m) != 0;
#pragma unroll
                for (int i = 0; i < m; ++i) { const float send = up ? rv[i] : rv[i + m], keep = up ? rv[i + m] : rv[i]; rv[i] = keep + __shfl_xor(send, m); }
            }
#pragma unroll
            for (int m = 2 * TT; m < 64; m <<= 1) rv[0] += __shfl_xor(rv[0], m);
            __syncthreads();
            if (lane < 2 * TT) red[F.wave * 2 * TT + lane] = rv[0];
            __syncthreads();
            if (tid < 2 * TT) { float s = 0.f;
#pragma unroll
                for (int w = 0; w < 8; ++w) s += red[w * 2 * TT + tid];
                const float other = __shfl_xor(s, 1);
                const float mean = ((tid & 1) ? other : s) * (1.f / DM), ex2 = ((tid & 1) ? s : other) * (1.f / DM);
                const float var = fmaxf(ex2 - mean * mean, 0.f);
                stat[tid] = (tid & 1) ? 1.f / sqrtf(var + EPS) : mean; }
            __syncthreads();
#pragma unroll
            for (int tt = 0; tt < TT; ++tt) {
                const float mean = stat[2 * tt], rstd = stat[2 * tt + 1];
                const float y0 = (a0[tt] - mean) * rstd * gv.x + bev.x, y1 = (a1[tt] - mean) * rstd * gv.y + bev.y;
                const size_t ro = (size_t)(tok0 + hf * TT + tt) * DM;
                const unsigned z = *((const GAS unsigned*)(SZC + ro) + tid);
                *((GAS unsigned*)(C + ro) + tid) = cvt_pk_bf16(silu(y0) * bf_lo(z), silu(y1) * bf_hi(z));
            }
        }
    }
}

#ifndef ONLY_PHASE
#define ONLY_PHASE -1
#endif
#ifndef ONLY_SUB
#define ONLY_SUB 0
#endif
#define SUB(k) (ONLY_SUB == 0 || ONLY_SUB == (k))
#define ONLY(k) (ONLY_PHASE < 0 || ONLY_PHASE == (k))
__global__ void __launch_bounds__(NWAVES * 64, 2) hybrid_fwd(Args args) {
    extern __shared__ __attribute__((aligned(16))) unsigned char lds[];
    Frame F;
    F.lds = (LAS unsigned char*)lds;
    F.MISC = (volatile LAS unsigned*)(F.lds + MISC_OFF);
    F.tid = threadIdx.x; F.lane = F.tid & 63; F.wave = __builtin_amdgcn_readfirstlane(F.tid >> 6);
    F.G = gridDim.x; { const int bx = blockIdx.x; F.vcu = (F.G % 8 == 0) ? (bx % 8) * (F.G / 8) + bx / 8 : bx; }
    F.ws = args.ws; F.ctl = (gu32*)(args.ws + WS_CTL);
    for (int u = F.tid; u < (LDS_BYTES - LDSCTL_OFF) / 4; u += NWAVES * 64) ((LAS unsigned*)(F.lds + LDSCTL_OFF))[u] = 0u;
    __syncthreads();
    XcdBarrier bar; bar.bar = (unsigned*)(F.ctl + CW_BAR); bar.x = 0; bar.st = nullptr;
#if !MK_PER_PHASE
    bar = xcd_barrier_post((unsigned*)(F.ctl + CW_BAR), F.MISC + 8);
#endif
#if MK_PER_PHASE
#define GRID_BAR() do { } while (0)
#else
#define GRID_BAR() xcd_barrier(bar)
#endif
    const int lo = args.ph_lo, hi = args.ph_hi;
#define WT ((bf16*)(F.ws + WS_WT))
#define XN ((bf16*)(F.ws + WS_XN))
#define Qb ((bf16*)(F.ws + WS_Q))
#define GA ((bf16*)(F.ws + WS_GA))
#define GLU ((bf16*)(F.ws + WS_GLU))
#define SZC ((bf16*)(F.ws + WS_SZC))
#define GC ((bf16*)(F.ws + WS_GC))
#define Cb ((bf16*)(F.ws + WS_C))
#define MB ((bf16*)(F.ws + WS_MB))
#define PH_BEGIN(k) if (ONLY(k) && lo <= l * NPHASE_L + (k) && l * NPHASE_L + (k) < hi) { { int t_ = threadIdx.x; asm volatile("" : "+v"(t_)); F.tid = t_; F.lane = t_ & 63; F.wave = __builtin_amdgcn_readfirstlane(t_ >> 6); unsigned char* w_ = args.ws; asm volatile("" : "+s"(w_)); F.ws = w_; F.ctl = (gu32*)(w_ + WS_CTL); }
#define PH_END(k) if (l * NPHASE_L + (k) + 1 < hi) GRID_BAR(); }
#pragma unroll 1
    for (int l = 0; l < DEPTH; ++l) {
        PH_BEGIN(0) { ph0_prologue(F, l, (l == 0) ? ARG_IN(0) : (const float*)ARG_OUT); }
        PH_END(0)
        PH_BEGIN(1) { pg8::Gemm g{XN, WT + WT_B * DM, M, 3072, DM}; pg8::StaticOrder S; S.init(M, 3072, F.G, (int)blockIdx.x);
            pg8::EpiBf16 E{Qb, DM, DM, (size_t)(WS_K - WS_Q) / 2};
            pg8::gemm_phase<pg8::EpiBf16, pg8::StaticOrder, PG8_ALIGN, PG8_SP2>(F.lds + RING_OFF, g, S, E); }
        PH_END(1)
        PH_BEGIN(2) { ph2_qknorm(F, l); }
        PH_END(2)
        PH_BEGIN(3) { ph3_gate(F, l); }
        PH_END(3)
        PH_BEGIN(4) { ph4_sparse(F, l); }
        PH_END(4)
        PH_BEGIN(5) { ph5_diag(F, l); }
        PH_END(5)
        PH_BEGIN(6) {
            if (SUB(1)) { pg8::Gemm g{XN, WT + WT_C * DM, M, 2048, DM}; pg8::StaticOrder S; S.init(M, 2048, F.G, (int)blockIdx.x);
              pg8::EpiC E{Qb, GA, ARG_IN(3) + (size_t)l * 2 * DM};
              pg8::gemm_phase<pg8::EpiC, pg8::StaticOrder, PG8_ALIGN, PG8_SP2>(F.lds + RING_OFF, g, S, E); }
            if (SUB(2)) { pg8::Gemm g{XN, WT + WT_A * DM, M, 4096, DM}; pg8::StaticOrder S; S.init(M, 4096, F.G, (int)blockIdx.x);
              pg8::EpiA E{GLU, SZC, GC, ARG_IN(3) + (size_t)l * 2 * DM + DM};
              pg8::gemm_phase<pg8::EpiA, pg8::StaticOrder, PG8_ALIGN, PG8_SP2>(F.lds + RING_OFF, g, S, E); } }
        PH_END(6)
        PH_BEGIN(7) { ph7_conv(F, l); }
        PH_END(7)
        PH_BEGIN(8) {
            if (SUB(1)) { pg8::Gemm g{Qb, WT + WT_PA * DM, M, DM, DM}; pg8::StaticOrder S; S.init(M, DM, F.G, (int)blockIdx.x);
              pg8::EpiM<false> E{MB, GA};
              pg8::gemm_phase<pg8::EpiM<false>, pg8::StaticOrder, PG8_ALIGN, PG8_SP2>(F.lds + RING_OFF, g, S, E); }
            if (SUB(2)) { pg8::Gemm g{Cb, WT + WT_PC * DM, M, DM, DM}; pg8::StaticOrder S; S.init(M, DM, F.G, (int)blockIdx.x);
              pg8::EpiM<true> E{MB, GC};
              pg8::gemm_phase<pg8::EpiM<true>, pg8::StaticOrder, PG8_ALIGN, PG8_SP2>(F.lds + RING_OFF, g, S, E); } }
        PH_END(8)
        PH_BEGIN(9) { pg8::Gemm g{MB, WT + WT_O * DM, M, DM, DM}; pg8::StaticOrder S; S.init(M, DM, F.G, (int)blockIdx.x);
            pg8::EpiOut E{(l == 0) ? ARG_IN(0) : (const float*)ARG_OUT, ARG_OUT};
            pg8::gemm_phase<pg8::EpiOut, pg8::StaticOrder, PG8_ALIGN, PG8_SP2>(F.lds + RING_OFF, g, S, E); }
        PH_END(9)
    }
}

extern "C" void kernel_launch(void* const* d_in, const int* in_sizes, int n_in, void* d_out, int out_size, void* d_ws, size_t ws_size, hipStream_t stream) {
    static int grid = 0;
    if (grid == 0) {
        if (n_in != 13 || in_sizes[0] != M * DM || out_size != M * DM || ws_size < WS_END) {
            fprintf(stderr, "kernel_launch: built for 13 inputs, x/out of %d floats, >= %zu bytes of workspace; got n_in %d, in0 %d, out %d, ws %zu; nothing launched\n", M * DM, (size_t)WS_END, n_in, n_in > 0 ? in_sizes[0] : -1, out_size, ws_size);
            grid = -1; return; }
        int dev = 0, cus = 0, per_cu = 0;
        if (hipGetDevice(&dev) != hipSuccess || hipDeviceGetAttribute(&cus, hipDeviceAttributeMultiprocessorCount, dev) != hipSuccess) { fprintf(stderr, "kernel_launch: device query failed\n"); grid = -1; return; }
        if (hipFuncSetAttribute((const void*)hybrid_fwd, hipFuncAttributeMaxDynamicSharedMemorySize, LDS_BYTES) != hipSuccess) { fprintf(stderr, "kernel_launch: hipFuncSetAttribute failed\n"); grid = -1; return; }
        if (hipOccupancyMaxActiveBlocksPerMultiprocessor(&per_cu, (const void*)hybrid_fwd, NWAVES * 64, LDS_BYTES) != hipSuccess || per_cu < 1)
            fprintf(stderr, "kernel_launch: note: occupancy query reports %d workgroups per CU\n", per_cu);
        (void)hipGetLastError();
        grid = cus;
    }
    if (grid < 0) return;
    if (hipMemsetAsync((char*)d_ws + WS_CTL, 0, CTL_ZERO_BYTES, stream) != hipSuccess) { fprintf(stderr, "kernel_launch: hipMemsetAsync failed\n"); return; }
    Args a{};
    for (int i = 0; i < 13; ++i) a.in[i] = (const float*)d_in[i];
    a.out = (float*)d_out; a.ws = (unsigned char*)d_ws;
#if MK_PER_PHASE
    for (int ph = 0; ph < NPHASES; ++ph) { a.ph_lo = ph; a.ph_hi = ph + 1; hipLaunchKernelGGL(hybrid_fwd, dim3(grid), dim3(NWAVES * 64), LDS_BYTES, stream, a); }
#else
    a.ph_lo = 0; a.ph_hi = NPHASES;
    hipLaunchKernelGGL(hybrid_fwd, dim3(grid), dim3(NWAVES * 64), LDS_BYTES, stream, a);
#endif
    const hipError_t le = hipPeekAtLastError();
    if (le != hipSuccess) fprintf(stderr, "kernel_launch: launch failed: %s\n", hipGetErrorName(le));
}
```

```cpp
#include <hip/hip_runtime.h>
#include <cstdio>
#include <cstdint>
namespace pg8 {
#define PG8_LAS __attribute__((address_space(3)))
typedef unsigned short bf16_t;
typedef short bf16x8 __attribute__((ext_vector_type(8)));
typedef float f32x4 __attribute__((ext_vector_type(4)));
typedef unsigned u32x4 __attribute__((ext_vector_type(4)));
constexpr int BM = 256, BK = 64, HALF = 128, HTB = HALF * BK * 2  , STAGE_BYTES = 8 * HTB, NXCD = 8, WGM = 8;

__host__ __device__ __forceinline__ int lds_byte(int r, int c) { const int st = (r >> 4) * 2 + (c >> 5), rr = r & 15, cc = c & 31, ob = rr * 64 + cc * 2; return st * 1024 + (ob ^ (((ob >> 9) & 1) << 5)); }
__host__ __device__ __forceinline__ void stage_rc(int b, int& R, int& C) { const int st = b / 1024, sb = b % 1024, swz = sb ^ (((sb >> 9) & 1) << 5); R = (st >> 1) * 16 + swz / 64; C = (st & 1) * 32 + (swz % 64) / 2; }
__host__ __device__ __forceinline__ int perm32(int rho) { const int n = rho >> 4, i = rho & 15; return 8 * (i >> 2) + 4 * n + (i & 3); }

struct Unit { int pm, pn; };
struct Gemm { const bf16_t* A; const bf16_t* Bt; int M, N, K; };

struct StaticOrder {
    int nM, nN, nwg, G, c;
    __host__ __device__ void init(int M, int N, int G_, int c_) { nM = M / BM; nN = N / BM; nwg = nM * nN; G = G_; c = c_; }
    __host__ __device__ bool next(int i, Unit& u) const {
        const long L = (long)i * G + c; if (L >= nwg) return false;
        int wgid = (int)L; { const int q = nwg / NXCD, r = nwg % NXCD, xcd = wgid % NXCD, off = wgid / NXCD; wgid = (xcd < r ? xcd * (q + 1) : r * (q + 1) + (xcd - r) * q) + off; }
        const int nig = WGM * nN, gid = wgid / nig, fm = gid * WGM, gsz = (nM - fm) < WGM ? (nM - fm) : WGM;
        u.pm = fm + ((wgid % nig) % gsz); u.pn = (wgid % nig) / gsz; return true;
    }
    __device__ __forceinline__ void a_ready(const Unit&) const {}
    __device__ __forceinline__ void done(const Unit&) const {}
};


typedef float f32x2 __attribute__((ext_vector_type(2)));
typedef __bf16 bf16x2_t __attribute__((ext_vector_type(2)));
__device__ __forceinline__ unsigned cvt_pk_bf16(float lo, float hi) { f32x2 v = {lo, hi}; bf16x2_t b = __builtin_convertvector(v, bf16x2_t); return __builtin_bit_cast(unsigned, b); }
__device__ __forceinline__ float bf_lo(unsigned w) { return __builtin_bit_cast(float, w << 16); }
__device__ __forceinline__ float bf_hi(unsigned w) { return __builtin_bit_cast(float, w & 0xffff0000u); }
__device__ __forceinline__ float sigm(float x) { return __builtin_amdgcn_rcpf(1.f + __expf(-x)); }
__device__ __forceinline__ float silu(float x) { return x * sigm(x); }
__device__ __forceinline__ u32x4 pack8(const f32x4 a, const f32x4 b) { u32x4 w; w.x = cvt_pk_bf16(a[0], a[1]); w.y = cvt_pk_bf16(a[2], a[3]); w.z = cvt_pk_bf16(b[0], b[1]); w.w = cvt_pk_bf16(b[2], b[3]); return w; }
__device__ __forceinline__ void unpack8(const u32x4 w, f32x4& a, f32x4& b) { a = (f32x4){bf_lo(w.x), bf_hi(w.x), bf_lo(w.y), bf_hi(w.y)}; b = (f32x4){bf_lo(w.z), bf_hi(w.z), bf_lo(w.w), bf_hi(w.w)}; }

struct EpiBf16 {
    static constexpr bool PERM = true, AFTER_DRAIN = false;
    bf16_t* O; int ldc; int split_cols; size_t split_stride;
    __device__ __forceinline__ void operator()(const f32x4 (&acc)[2][2][4][2], const Unit& u, int wr, int wc, int fr, int fq) const {
        const int row0 = u.pm * BM + wr * 64 + fr; int colt = u.pn * BM; bf16_t* base = O;
        if (split_cols) { const int t = colt / split_cols; base += (size_t)t * split_stride; colt -= t * split_cols; }
        const int col0 = colt + wc * 32 + 8 * fq;
#pragma unroll
        for (int ai = 0; ai < 2; ++ai)
#pragma unroll
            for (int m = 0; m < 4; ++m) { bf16_t* rowp = base + (size_t)(row0 + ai * HALF + m * 16) * ldc + col0;
#pragma unroll
                for (int bj = 0; bj < 2; ++bj) *(u32x4*)(rowp + bj * HALF) = pack8(acc[ai][bj][m][0], acc[ai][bj][m][1]); }
    }
};

struct RowRstd { PG8_LAS float* part; PG8_LAS float* tab; PG8_LAS int* words; const float* ss;
    __device__ __forceinline__ void ensure(int pm, int wid, int lane) const {
        const int have_p = __builtin_amdgcn_readfirstlane(words[0]), have_t = __builtin_amdgcn_readfirstlane(words[1]);
        if (have_t == pm) return;
        asm volatile("s_waitcnt lgkmcnt(0)" ::: "memory"); __builtin_amdgcn_s_barrier(); asm volatile("" ::: "memory");
        if (have_p != pm) {
            const char* src = (const char*)ss + (size_t)pm * 256 * 64;
#pragma unroll
            for (int i = 0; i < 2; ++i) { const int p = wid * 2 + i;
                __builtin_amdgcn_global_load_lds((const __attribute__((address_space(1))) unsigned*)(src + p * 1024 + lane * 16), (PG8_LAS unsigned*)((PG8_LAS char*)part + p * 1024), 16, 0, 0); }
            asm volatile("s_waitcnt vmcnt(0)" ::: "memory"); __builtin_amdgcn_s_barrier(); asm volatile("" ::: "memory");
        }
        const int tid = wid * 64 + lane;
        if (tid < 256) { const PG8_LAS f32x4* p = (const PG8_LAS f32x4*)(part + tid * 16); const f32x4 a = p[0], b = p[1], c = p[2], d = p[3];
            const float s = ((a[0] + a[1]) + (a[2] + a[3])) + ((b[0] + b[1]) + (b[2] + b[3])) + ((c[0] + c[1]) + (c[2] + c[3])) + ((d[0] + d[1]) + (d[2] + d[3]));
            tab[tid] = 1.0f / sqrtf(s * (1.0f / 1024.0f) + 1e-6f); }
        if (tid == 0) { words[0] = pm; words[1] = pm; }
        asm volatile("s_waitcnt lgkmcnt(0)" ::: "memory"); __builtin_amdgcn_s_barrier(); asm volatile("" ::: "memory");
    }
    __device__ __forceinline__ float get(int rl) const { return tab[rl]; } };
struct EpiQKV {
    static constexpr bool PERM = true, AFTER_DRAIN = false;
    bf16_t* Q; size_t split_stride; const float* gq; const float* gk; const unsigned short* rope; float* kmean; float qscale; PG8_LAS unsigned char* xs; int seq; RowRstd rstd;
    __device__ __forceinline__ void operator()(f32x4 (&acc)[2][2][4][2], const Unit& u, int wr, int wc, int fr_in, int fq_in) const {
        int fr = fr_in, fq = fq_in; asm volatile("" : "+v"(fr), "+v"(fq));
        u32x4 tb[2][4];
        if ((u.pn >> 2) != 2 && wc == 0) {
#pragma unroll
            for (int ai = 0; ai < 2; ++ai)
#pragma unroll
                for (int m = 0; m < 4; ++m) { const int row = u.pm * BM + ai * HALF + wr * 64 + m * 16 + fr;
                    tb[ai][m] = *(const u32x4*)((const char*)rope + (unsigned)((row & (seq - 1)) * 64 + (fq >> 1) * 32 + (fq & 1) * 16)); }
        }
        rstd.ensure(u.pm, wr * 4 + wc, fq * 16 + fr);
        { float rs[2][4];
#pragma unroll
          for (int ai = 0; ai < 2; ++ai)
#pragma unroll
            for (int m = 0; m < 4; ++m) rs[ai][m] = rstd.get(ai * HALF + wr * 64 + m * 16 + fr);
#pragma unroll
          for (int ai = 0; ai < 2; ++ai)
#pragma unroll
            for (int m = 0; m < 4; ++m)
#pragma unroll
                for (int bj = 0; bj < 2; ++bj) { acc[ai][bj][m][0] = acc[ai][bj][m][0] * rs[ai][m]; acc[ai][bj][m][1] = acc[ai][bj][m][1] * rs[ai][m]; } }
        const int sect = u.pn >> 2;
        char* base = (char*)(Q + (size_t)sect * split_stride);
        const unsigned off0 = (unsigned)(((u.pm * BM + wr * 64 + fr) * 1024 + (u.pn & 3) * BM + wc * 32 + 8 * fq) * 2);
        if (sect != 2) {
            PG8_LAS float* P = (PG8_LAS float*)xs;
#pragma unroll
            for (int ai = 0; ai < 2; ++ai)
#pragma unroll
                for (int m = 0; m < 4; ++m)
#pragma unroll
                    for (int bj = 0; bj < 2; ++bj) { const f32x4 a = acc[ai][bj][m][0], b = acc[ai][bj][m][1];
                        float s = (a[0] * a[0] + a[1] * a[1]) + (a[2] * a[2] + a[3] * a[3]) + (b[0] * b[0] + b[1] * b[1]) + (b[2] * b[2] + b[3] * b[3]);
                        s += __shfl_xor(s, 16); s += __shfl_xor(s, 32);
                        if (fq == 0) P[((ai * HALF + wr * 64 + m * 16 + fr) * 2 + bj) * 4 + wc] = s; }
            asm volatile("s_waitcnt lgkmcnt(0)" ::: "memory"); __builtin_amdgcn_s_barrier(); asm volatile("" ::: "memory");
            { const float* g = sect ? gk : gq;
              const f32x4 g0 = *(const f32x4*)(g + wc * 32 + 8 * fq), g1 = *(const f32x4*)(g + wc * 32 + 8 * fq + 4);
#pragma unroll
              for (int ai = 0; ai < 2; ++ai)
#pragma unroll
                for (int m = 0; m < 4; ++m) {
#pragma unroll
                    for (int bj = 0; bj < 2; ++bj) { const f32x4 pp = *(const PG8_LAS f32x4*)(P + ((ai * HALF + wr * 64 + m * 16 + fr) * 2 + bj) * 4);
                        const float rstd = __builtin_amdgcn_rsqf(((pp[0] + pp[1]) + (pp[2] + pp[3])) * (1.0f / 128.0f) + 1e-6f);
                        acc[ai][bj][m][0] = acc[ai][bj][m][0] * rstd * g0; acc[ai][bj][m][1] = acc[ai][bj][m][1] * rstd * g1; }
                    asm volatile("" ::: "memory"); } }
            if (wc == 0) {
                const bool lowhalf = fq < 2;
                typedef _Float16 h2_t __attribute__((ext_vector_type(2)));
#pragma unroll
                for (int ai = 0; ai < 2; ++ai)
#pragma unroll
                    for (int m = 0; m < 4; ++m) {
                        float cs[8], sn[8];
#pragma unroll
                        for (int w = 0; w < 4; ++w) { const unsigned own = tb[ai][m][w]; auto rr = __builtin_amdgcn_permlane32_swap(own, own, false, false); const unsigned oth = lowhalf ? rr[1] : rr[0];
                            const h2_t ho = __builtin_bit_cast(h2_t, own), hp = __builtin_bit_cast(h2_t, oth);
                            const float o0 = (float)ho[0], o1 = (float)ho[1], p0 = (float)hp[0], p1 = (float)hp[1];
                            cs[2 * w] = lowhalf ? o0 : p0; cs[2 * w + 1] = lowhalf ? o1 : p1; sn[2 * w] = lowhalf ? -p0 : o0; sn[2 * w + 1] = lowhalf ? -p1 : o1; }
#pragma unroll
                        for (int bj = 0; bj < 2; ++bj)
#pragma unroll
                            for (int i = 0; i < 4; ++i) {
                                { const float y = acc[ai][bj][m][0][i]; auto rr = __builtin_amdgcn_permlane32_swap(__builtin_bit_cast(unsigned, y), __builtin_bit_cast(unsigned, y), false, false);
                                  acc[ai][bj][m][0][i] = y * cs[i] + __builtin_bit_cast(float, lowhalf ? rr[1] : rr[0]) * sn[i]; }
                                { const float y = acc[ai][bj][m][1][i]; auto rr = __builtin_amdgcn_permlane32_swap(__builtin_bit_cast(unsigned, y), __builtin_bit_cast(unsigned, y), false, false);
                                  acc[ai][bj][m][1][i] = y * cs[4 + i] + __builtin_bit_cast(float, lowhalf ? rr[1] : rr[0]) * sn[4 + i]; }
                            }
                    }
            }
            if (sect == 1) {
                PG8_LAS float* KM = (PG8_LAS float*)(xs + 8192);
                float rv[16];
#pragma unroll
                for (int bj = 0; bj < 2; ++bj) { f32x4 c0 = acc[0][bj][0][0], c1 = acc[0][bj][0][1];
#pragma unroll
                    for (int ai = 0; ai < 2; ++ai)
#pragma unroll
                        for (int m = 0; m < 4; ++m) if (ai + m) { c0 += acc[ai][bj][m][0]; c1 += acc[ai][bj][m][1]; }
#pragma unroll
                    for (int i = 0; i < 4; ++i) { rv[bj * 8 + i] = c0[i]; rv[bj * 8 + 4 + i] = c1[i]; } }
#define TR_STEP(MM) { const bool up = (fr & (MM)) != 0; _Pragma("unroll") for (int i = 0; i < (MM); ++i) { const float send = up ? rv[i] : rv[i + (MM)], keep = up ? rv[i + (MM)] : rv[i]; rv[i] = keep + __shfl_xor(send, (MM)); } }
                TR_STEP(8) TR_STEP(4) TR_STEP(2) TR_STEP(1)
#undef TR_STEP
                KM[((wr * 4 + wc) * 4 + fq) * 16 + fr] = rv[0];
                asm volatile("s_waitcnt lgkmcnt(0)" ::: "memory"); __builtin_amdgcn_s_barrier(); asm volatile("" ::: "memory");
                const int tid = (wr * 4 + wc) * 64 + fq * 16 + fr;
                if (tid < 256) { const int bj = tid >> 7, d = tid & 127, w4 = d >> 5, q4 = (d >> 3) & 3, i = d & 7;
                    const float s = KM[((0 * 4 + w4) * 4 + q4) * 16 + bj * 8 + i] + KM[((1 * 4 + w4) * 4 + q4) * 16 + bj * 8 + i];
                    const int bb = u.pm >> 5, nb = u.pm & 31, head = (u.pn & 3) * 2 + bj;
                    kmean[((size_t)(bb * 8 + head) * 32 + nb) * 128 + d] = s * (1.0f / 256.0f); }
            }
        }
        const float osc = sect ? 1.f : qscale;
#pragma unroll
        for (int ai = 0; ai < 2; ++ai)
#pragma unroll
            for (int m = 0; m < 4; ++m)
#pragma unroll
                for (int bj = 0; bj < 2; ++bj) *(u32x4*)(base + off0 + (unsigned)((ai * HALF + m * 16) * 2048 + bj * 256)) = pack8(acc[ai][bj][m][0] * osc, acc[ai][bj][m][1] * osc);
    }
};
struct EpiC {
    static constexpr bool PERM = true, AFTER_DRAIN = false;
    const bf16_t* OA; bf16_t* AC; bf16_t* GA; const float* bias;
    __device__ __forceinline__ void operator()(const f32x4 (&acc)[2][2][4][2], const Unit& u, int wr, int wc, int fr, int fq) const {
        const int row0 = u.pm * BM + wr * 64 + fr;
        if (u.pn < 4) {
            const int col0 = u.pn * BM + wc * 32 + 8 * fq;
#pragma unroll
            for (int ai = 0; ai < 2; ++ai) {
                u32x4 ld[4][2];
#pragma unroll
                for (int m = 0; m < 4; ++m)
#pragma unroll
                    for (int bj = 0; bj < 2; ++bj) ld[m][bj] = __builtin_nontemporal_load((const u32x4*)(OA + (size_t)(row0 + ai * HALF + m * 16) * 1024 + col0 + bj * HALF));
#pragma unroll
                for (int m = 0; m < 4; ++m) { bf16_t* outp = AC + (size_t)(row0 + ai * HALF + m * 16) * 2048 + col0;
#pragma unroll
                    for (int bj = 0; bj < 2; ++bj) { f32x4 o0, o1; unpack8(ld[m][bj], o0, o1); const f32x4 z0 = acc[ai][bj][m][0], z1 = acc[ai][bj][m][1];
#pragma unroll
                        for (int i = 0; i < 4; ++i) { o0[i] *= silu(z0[i]); o1[i] *= silu(z1[i]); }
                        *(u32x4*)(outp + bj * HALF) = pack8(o0, o1); } }
                asm volatile("" ::: "memory"); }
        } else {
            const int col0 = (u.pn - 4) * BM + wc * 32 + 8 * fq;
            f32x4 bb[2][2];
#pragma unroll
            for (int bj = 0; bj < 2; ++bj) { bb[bj][0] = *(const f32x4*)(bias + col0 + bj * HALF); bb[bj][1] = *(const f32x4*)(bias + col0 + bj * HALF + 4); }
#pragma unroll
            for (int bj = 0; bj < 2; ++bj) { const f32x4 b0 = bb[bj][0], b1 = bb[bj][1];
#pragma unroll
                for (int ai = 0; ai < 2; ++ai)
#pragma unroll
                    for (int m = 0; m < 4; ++m) { bf16_t* rowp = GA + (size_t)(row0 + ai * HALF + m * 16) * 1024 + col0 + bj * HALF; f32x4 g0 = acc[ai][bj][m][0] + b0, g1 = acc[ai][bj][m][1] + b1;
#pragma unroll
                        for (int i = 0; i < 4; ++i) { g0[i] = sigm(g0[i]); g1[i] = sigm(g1[i]); }
                        *(u32x4*)rowp = pack8(g0, g1); } }
        }
    }
};
struct EpiA {
    static constexpr bool PERM = true, AFTER_DRAIN = false;
    bf16_t* GLU; bf16_t* SZC; bf16_t* GC; const float* bias;
    __device__ __forceinline__ void operator()(const f32x4 (&acc)[2][2][4][2], const Unit& u, int wr, int wc, int fr, int fq) const {
        const int row0 = u.pm * BM + wr * 64 + fr;
        if (u.pn < 8) {
            const int col0 = u.pn * HALF + wc * 32 + 8 * fq;
#pragma unroll
            for (int ai = 0; ai < 2; ++ai)
#pragma unroll
                for (int m = 0; m < 4; ++m) { bf16_t* rowp = GLU + (size_t)(row0 + ai * HALF + m * 16) * 1024 + col0; f32x4 a0 = acc[ai][0][m][0], a1 = acc[ai][0][m][1]; const f32x4 b0 = acc[ai][1][m][0], b1 = acc[ai][1][m][1];
#pragma unroll
                    for (int i = 0; i < 4; ++i) { a0[i] *= sigm(b0[i]); a1[i] *= sigm(b1[i]); }
                    *(u32x4*)rowp = pack8(a0, a1); }
        } else if (u.pn < 12) {
            const int col0 = (u.pn - 8) * BM + wc * 32 + 8 * fq;
#pragma unroll
            for (int ai = 0; ai < 2; ++ai)
#pragma unroll
                for (int m = 0; m < 4; ++m) { bf16_t* rowp = SZC + (size_t)(row0 + ai * HALF + m * 16) * 1024 + col0;
#pragma unroll
                    for (int bj = 0; bj < 2; ++bj) { f32x4 z0 = acc[ai][bj][m][0], z1 = acc[ai][bj][m][1];
#pragma unroll
                        for (int i = 0; i < 4; ++i) { z0[i] = silu(z0[i]); z1[i] = silu(z1[i]); }
                        *(u32x4*)(rowp + bj * HALF) = pack8(z0, z1); } }
        } else {
            const int col0 = (u.pn - 12) * BM + wc * 32 + 8 * fq;
            f32x4 bb[2][2];
#pragma unroll
            for (int bj = 0; bj < 2; ++bj) { bb[bj][0] = *(const f32x4*)(bias + col0 + bj * HALF); bb[bj][1] = *(const f32x4*)(bias + col0 + bj * HALF + 4); }
#pragma unroll
            for (int bj = 0; bj < 2; ++bj) { const f32x4 b0 = bb[bj][0], b1 = bb[bj][1];
#pragma unroll
                for (int ai = 0; ai < 2; ++ai)
#pragma unroll
                    for (int m = 0; m < 4; ++m) { bf16_t* rowp = GC + (size_t)(row0 + ai * HALF + m * 16) * 1024 + col0 + bj * HALF; f32x4 g0 = acc[ai][bj][m][0] + b0, g1 = acc[ai][bj][m][1] + b1;
#pragma unroll
                        for (int i = 0; i < 4; ++i) { g0[i] = sigm(g0[i]); g1[i] = sigm(g1[i]); }
                        *(u32x4*)rowp = pack8(g0, g1); } }
        }
    }
};
struct EpiCA {
    static constexpr bool PERM = true, AFTER_DRAIN = false;
    EpiC c; EpiA a; RowRstd rstd;
    __device__ __forceinline__ void operator()(f32x4 (&acc)[2][2][4][2], const Unit& u, int wr, int wc, int fr, int fq) const {
        rstd.ensure(u.pm, wr * 4 + wc, fq * 16 + fr);
        { int frx = fr; asm volatile("" : "+v"(frx));
          float rs[2][4];
#pragma unroll
          for (int ai = 0; ai < 2; ++ai)
#pragma unroll
            for (int m = 0; m < 4; ++m) rs[ai][m] = rstd.get(ai * HALF + wr * 64 + m * 16 + frx);
#pragma unroll
          for (int ai = 0; ai < 2; ++ai)
#pragma unroll
            for (int m = 0; m < 4; ++m)
#pragma unroll
                for (int bj = 0; bj < 2; ++bj) { acc[ai][bj][m][0] = acc[ai][bj][m][0] * rs[ai][m]; acc[ai][bj][m][1] = acc[ai][bj][m][1] * rs[ai][m]; } }
        if (u.pn < 8) c(acc, u, wr, wc, fr, fq); else { Unit v = u; v.pn = u.pn - 8; a(acc, v, wr, wc, fr, fq); }
    }
};
struct EpiM {
    static constexpr bool PERM = true, AFTER_DRAIN = false, MID = true;
    bf16_t* Mb; const bf16_t* GA; const bf16_t* GC;
    __device__ __forceinline__ void mid(f32x4 (&acc)[2][2][4][2], const Unit& u, int wr, int wc, int fr_in, int fq_in) const {
        int fr = fr_in, fq = fq_in; asm volatile("" : "+v"(fr), "+v"(fq));
        const int row0 = u.pm * BM + wr * 64 + fr, col0 = u.pn * BM + wc * 32 + 8 * fq;
#pragma unroll
        for (int ai = 0; ai < 2; ++ai)
#pragma unroll
            for (int mh = 0; mh < 2; ++mh) {
                u32x4 la[2][2], lc[2][2];
#pragma unroll
                for (int m2 = 0; m2 < 2; ++m2)
#pragma unroll
                    for (int bj = 0; bj < 2; ++bj) { const unsigned off = (unsigned)((row0 + ai * HALF + (mh * 2 + m2) * 16) * 1024 + col0 + bj * HALF); la[m2][bj] = *(const u32x4*)(GA + off); lc[m2][bj] = *(const u32x4*)(GC + off); }
#pragma unroll
                for (int m2 = 0; m2 < 2; ++m2)
#pragma unroll
                    for (int bj = 0; bj < 2; ++bj) { const int m = mh * 2 + m2; f32x4 a0, a1, c0, c1; unpack8(la[m2][bj], a0, a1); unpack8(lc[m2][bj], c0, c1);
#pragma unroll
                        for (int i = 0; i < 4; ++i) { acc[ai][bj][m][0][i] *= a0[i] * __builtin_amdgcn_rcpf(c0[i]); acc[ai][bj][m][1][i] *= a1[i] * __builtin_amdgcn_rcpf(c1[i]); } }
                asm volatile("" ::: "memory"); }
    }
    __device__ __forceinline__ void operator()(const f32x4 (&acc)[2][2][4][2], const Unit& u, int wr, int wc, int fr_in, int fq_in) const {
        int fr = fr_in, fq = fq_in; asm volatile("" : "+v"(fr), "+v"(fq));
        const int row0 = u.pm * BM + wr * 64 + fr, col0 = u.pn * BM + wc * 32 + 8 * fq;
#pragma unroll
        for (int ai = 0; ai < 2; ++ai) {
            u32x4 lc[4][2];
#pragma unroll
            for (int m = 0; m < 4; ++m)
#pragma unroll
                for (int bj = 0; bj < 2; ++bj) lc[m][bj] = *(const u32x4*)(GC + (unsigned)((row0 + ai * HALF + m * 16) * 1024 + col0 + bj * HALF));
#pragma unroll
            for (int m = 0; m < 4; ++m)
#pragma unroll
                for (int bj = 0; bj < 2; ++bj) { f32x4 c0, c1; unpack8(lc[m][bj], c0, c1);
                    *(u32x4*)(Mb + (unsigned)((row0 + ai * HALF + m * 16) * 1024 + col0 + bj * HALF)) = pack8(c0 * acc[ai][bj][m][0], c1 * acc[ai][bj][m][1]); }
            asm volatile("" ::: "memory"); }
    }
};
struct EpiOut {
    static constexpr bool PERM = false, AFTER_DRAIN = false;
    const float* xres; float* out; bf16_t* xn; const float* gnext; float* ss;
    __device__ __forceinline__ void operator()(const f32x4 (&acc)[2][2][4][2], const Unit& u, int wr, int wc, int fr_in, int fq_in) const {
        int fr = fr_in, fq = fq_in; asm volatile("" : "+v"(fr), "+v"(fq));
        const int row0 = u.pm * BM + wr * 64 + fr, col0 = u.pn * BM + wc * 32 + 4 * fq;
        f32x4 gv[2][2];
        if (xn) {
#pragma unroll
            for (int bj = 0; bj < 2; ++bj)
#pragma unroll
                for (int n = 0; n < 2; ++n) gv[bj][n] = *(const f32x4*)(gnext + col0 + bj * HALF + n * 16); }
#pragma unroll
        for (int ai = 0; ai < 2; ++ai) {
            f32x4 xr[4][2][2];
#pragma unroll
            for (int m = 0; m < 4; ++m)
#pragma unroll
                for (int bj = 0; bj < 2; ++bj)
#pragma unroll
                    for (int n = 0; n < 2; ++n) xr[m][bj][n] = *(const f32x4*)(xres + (unsigned)((row0 + ai * HALF + m * 16) * 1024 + col0) + bj * HALF + n * 16);
#pragma unroll
            for (int m = 0; m < 4; ++m) { const unsigned off = (unsigned)((row0 + ai * HALF + m * 16) * 1024 + col0); float s = 0.f;
#pragma unroll
                for (int bj = 0; bj < 2; ++bj)
#pragma unroll
                    for (int n = 0; n < 2; ++n) { const f32x4 o = xr[m][bj][n] + acc[ai][bj][m][n]; *(f32x4*)(out + off + bj * HALF + n * 16) = o;
                        if (xn) { s += (o[0] * o[0] + o[1] * o[1]) + (o[2] * o[2] + o[3] * o[3]); const f32x4 y = o * gv[bj][n];
                            *(unsigned long long*)(xn + off + bj * HALF + n * 16) = (unsigned long long)cvt_pk_bf16(y[0], y[1]) | ((unsigned long long)cvt_pk_bf16(y[2], y[3]) << 32); } }
                if (xn) { s += __shfl_xor(s, 16); s += __shfl_xor(s, 32); if (fq == 0) ss[(unsigned)((row0 + ai * HALF + m * 16) * 16 + u.pn * 4 + wc)] = s; } }
            asm volatile("" ::: "memory"); }
    }
};

template <class T, class = void> struct epi_has_mid { static constexpr bool value = false; };
template <class T> struct epi_has_mid<T, decltype((void)T::MID)> { static constexpr bool value = T::MID; };
template <class Epi, class Sched, bool ALIGN_EPI = false, bool SP2 = false>
__device__ __forceinline__ void gemm_phase(PG8_LAS unsigned char* lds, const Gemm g, const Sched& S, const Epi& E) {
    int tid_ = threadIdx.x; asm volatile("" : "+v"(tid_));
    const int tid = tid_, wid = __builtin_amdgcn_readfirstlane(tid >> 6), lane = tid & 63, wr = wid >> 2, wc = wid & 3, fr = lane & 15, fq = lane >> 4;
    const int K = g.K, nt = K / BK;
    unsigned voffA[2], voffB[2];
#pragma unroll
    for (int i = 0; i < 2; ++i) { int R, C; stage_rc(tid * 16 + i * 8192, R, C); const int Rb = Epi::PERM ? ((R & ~31) + perm32(R & 31)) : R;
        voffA[i] = (unsigned)(R * K + C) * 2u; voffB[i] = (unsigned)(Rb * K + C) * 2u; }
    const size_t kstep = (size_t)(BK * 2);
    const size_t hstep = (size_t)HALF * K * 2;
    const size_t tstep = 2 * hstep;
    const unsigned ldsw = (unsigned)wid * 1024u;
    const int aoff = lds_byte(wr * 64 + fr, fq * 8), boff = lds_byte(wc * 32 + fr, fq * 8);
#define PG8_SA(b, h) (((b) * 2 + (h)) * HTB)
#define PG8_SB(b, h) ((4 + (b) * 2 + (h)) * HTB)
#define PG8_STAGE(bufoff, gbase, voff) do { _Pragma("unroll") for (int _i = 0; _i < 2; ++_i) \
        __builtin_amdgcn_global_load_lds((const unsigned*)((const char*)(gbase) + (voff)[_i]), (PG8_LAS unsigned*)(lds + (bufoff) + ldsw + _i * 8192), 16, 0, 0); } while (0)
#define PG8_LDA(dst, b, h) do { _Pragma("unroll") for (int m = 0; m < 4; ++m) _Pragma("unroll") for (int k = 0; k < 2; ++k) dst[m][k] = *(const PG8_LAS bf16x8*)(lds + PG8_SA(b, h) + aoff + m * 2048 + k * 1024); } while (0)
#define PG8_LDB(dst, b, h) do { _Pragma("unroll") for (int n = 0; n < 2; ++n) _Pragma("unroll") for (int k = 0; k < 2; ++k) dst[n][k] = *(const PG8_LAS bf16x8*)(lds + PG8_SB(b, h) + boff + n * 2048 + k * 1024); } while (0)
#define PG8_MMA(ai, bj, At, Bt) do { __builtin_amdgcn_s_setprio(1); _Pragma("unroll") for (int m = 0; m < 4; ++m) _Pragma("unroll") for (int n = 0; n < 2; ++n) _Pragma("unroll") for (int k = 0; k < 2; ++k) \
        acc[ai][bj][m][n] = __builtin_amdgcn_mfma_f32_16x16x32_bf16(Bt[n][k], At[m][k], acc[ai][bj][m][n], 0, 0, 0); __builtin_amdgcn_s_setprio(0); } while (0)
#define PG8_WAIT_V(n) asm volatile("s_waitcnt vmcnt(" #n ")" ::: "memory")
#define PG8_WAIT_L(n) asm volatile("s_waitcnt lgkmcnt(" #n ")" ::: "memory")
#define PG8_BAR __builtin_amdgcn_s_barrier()
#define PG8_SCHED __builtin_amdgcn_sched_barrier(0)
    Unit cur, nxt; int ui = 0;
    if (!S.next(0, cur)) return;
    f32x4 acc[2][2][4][2];
#pragma unroll
    for (int a = 0; a < 2; ++a)
#pragma unroll
        for (int b = 0; b < 2; ++b)
#pragma unroll
            for (int m = 0; m < 4; ++m)
#pragma unroll
                for (int n = 0; n < 2; ++n) acc[a][b][m][n] = (f32x4){0.f, 0.f, 0.f, 0.f};
    bf16x8 At[4][2], B0[2][2], B1[2][2];
    const char* cA = (const char*)g.A + (size_t)cur.pm * tstep; const char* cB = (const char*)g.Bt + (size_t)cur.pn * tstep;
    S.a_ready(cur);
    if constexpr (SP2) {
        PG8_STAGE(PG8_SB(0, 0), cB, voffB); PG8_STAGE(PG8_SB(0, 1), cB + hstep, voffB); PG8_STAGE(PG8_SA(0, 0), cA, voffA); PG8_STAGE(PG8_SA(0, 1), cA + hstep, voffA);
        if (wr == 1) PG8_BAR;
        PG8_WAIT_V(2); PG8_BAR;
        PG8_STAGE(PG8_SB(1, 0), cB + kstep, voffB); PG8_STAGE(PG8_SA(1, 0), cA + kstep, voffA); PG8_STAGE(PG8_SB(1, 1), cB + hstep + kstep, voffB);
        PG8_WAIT_V(6); PG8_BAR;
    } else {
        PG8_STAGE(PG8_SB(0, 0), cB, voffB); PG8_STAGE(PG8_SA(0, 0), cA, voffA); PG8_STAGE(PG8_SB(0, 1), cB + hstep, voffB); PG8_STAGE(PG8_SA(0, 1), cA + hstep, voffA);
        if (wr == 1) PG8_BAR;
        PG8_WAIT_V(4); PG8_BAR;
        PG8_STAGE(PG8_SB(1, 0), cB + kstep, voffB); PG8_STAGE(PG8_SA(1, 0), cA + kstep, voffA); PG8_STAGE(PG8_SB(1, 1), cB + hstep + kstep, voffB);
        PG8_WAIT_V(6); PG8_BAR;
    }
    for (;;) {
        const bool has_next = S.next(ui + 1, nxt);
        const char* nA = has_next ? (const char*)g.A + (size_t)nxt.pm * tstep : cA; const char* nB = has_next ? (const char*)g.Bt + (size_t)nxt.pn * tstep : cB;
        for (int t = 0; t < nt; t += 2) {
            if constexpr (epi_has_mid<Epi>::value) { if (t == nt / 2) E.mid(acc, cur, wr, wc, fr, fq); }
            const bool last = (t == nt - 2);
            const char* a1 = cA + (size_t)(t + 1) * kstep;
            const char* a2 = last ? nA : cA + (size_t)(t + 2) * kstep; const char* b2 = last ? nB : cB + (size_t)(t + 2) * kstep;
            const char* a3 = a2 + kstep; const char* b3 = b2 + kstep;
            if (last && has_next) S.a_ready(nxt);
            if constexpr (SP2) {
            PG8_LDB(B0, 0, 0); PG8_LDB(B1, 0, 1); PG8_SCHED; PG8_LDA(At, 0, 0); PG8_STAGE(PG8_SA(1, 1), a1 + hstep, voffA);
            PG8_WAIT_V(8); PG8_WAIT_L(0); PG8_BAR; PG8_MMA(0, 0, At, B0); PG8_MMA(0, 1, At, B1); PG8_BAR; PG8_SCHED;
            PG8_LDA(At, 0, 1); PG8_STAGE(PG8_SB(0, 0), b2, voffB); PG8_STAGE(PG8_SB(0, 1), b2 + hstep, voffB); PG8_STAGE(PG8_SA(0, 0), a2, voffA);
            PG8_WAIT_V(8); PG8_WAIT_L(0); PG8_BAR; PG8_MMA(1, 0, At, B0); PG8_MMA(1, 1, At, B1); PG8_BAR; PG8_SCHED;
            PG8_LDB(B0, 1, 0); PG8_LDB(B1, 1, 1); PG8_SCHED; PG8_LDA(At, 1, 0); PG8_STAGE(PG8_SA(0, 1), a2 + hstep, voffA);
            PG8_WAIT_V(8); PG8_WAIT_L(0); PG8_BAR; PG8_MMA(0, 0, At, B0); PG8_MMA(0, 1, At, B1); PG8_BAR; PG8_SCHED;
            PG8_LDA(At, 1, 1); PG8_STAGE(PG8_SB(1, 0), b3, voffB); PG8_STAGE(PG8_SB(1, 1), b3 + hstep, voffB); PG8_STAGE(PG8_SA(1, 0), a3, voffA);
            PG8_WAIT_V(8); PG8_WAIT_L(0); PG8_BAR; PG8_MMA(1, 0, At, B0); PG8_MMA(1, 1, At, B1); PG8_BAR; PG8_SCHED;
            } else {
            PG8_LDB(B0, 0, 0); PG8_SCHED; PG8_LDA(At, 0, 0); PG8_STAGE(PG8_SA(1, 1), a1 + hstep, voffA);
            PG8_WAIT_L(8); PG8_BAR; PG8_WAIT_L(0); PG8_MMA(0, 0, At, B0); PG8_BAR; PG8_SCHED;
            PG8_LDB(B1, 0, 1); PG8_STAGE(PG8_SB(0, 0), b2, voffB);
            PG8_BAR; PG8_WAIT_L(0); PG8_MMA(0, 1, At, B1); PG8_BAR;
            PG8_LDA(At, 0, 1); PG8_STAGE(PG8_SA(0, 0), a2, voffA);
            PG8_BAR; PG8_WAIT_L(0); PG8_MMA(1, 0, At, B0); PG8_BAR; PG8_SCHED;
            PG8_STAGE(PG8_SB(0, 1), b2 + hstep, voffB);
            PG8_WAIT_V(6); PG8_BAR; PG8_MMA(1, 1, At, B1); PG8_BAR;
            PG8_LDB(B0, 1, 0); PG8_SCHED; PG8_LDA(At, 1, 0); PG8_STAGE(PG8_SA(0, 1), a2 + hstep, voffA);
            PG8_WAIT_L(8); PG8_BAR; PG8_WAIT_L(0); PG8_MMA(0, 0, At, B0); PG8_BAR; PG8_SCHED;
            PG8_LDB(B1, 1, 1); PG8_STAGE(PG8_SB(1, 0), b3, voffB);
            PG8_BAR; PG8_WAIT_L(0); PG8_MMA(0, 1, At, B1); PG8_BAR;
            PG8_LDA(At, 1, 1); PG8_STAGE(PG8_SA(1, 0), a3, voffA);
            PG8_BAR; PG8_WAIT_L(0); PG8_MMA(1, 0, At, B0); PG8_BAR; PG8_SCHED;
            PG8_STAGE(PG8_SB(1, 1), b3 + hstep, voffB);
            PG8_WAIT_V(6); PG8_BAR; PG8_MMA(1, 1, At, B1); PG8_BAR;
            }
        }
        if constexpr (ALIGN_EPI) { if (wr == 0) PG8_BAR; }
#if defined(PROBE_PHASE) && (PROBE_PHASE == 400 || PROBE_PHASE == 401)
        { __builtin_amdgcn_sched_barrier(0); const unsigned long long t0_ = __builtin_amdgcn_s_memrealtime(); __builtin_amdgcn_sched_barrier(0);
          if constexpr (!Epi::AFTER_DRAIN) { E(acc, cur, wr, wc, fr, fq); S.done(cur); }
          if (PROBE_PHASE == 400) asm volatile("s_waitcnt vmcnt(0)" ::: "memory"); __builtin_amdgcn_sched_barrier(0); const unsigned long long t1_ = __builtin_amdgcn_s_memrealtime();
          if (lane == 0 && wid == 0) *(volatile PG8_LAS unsigned*)(lds + 131072 + 320 + 64) += (unsigned)(t1_ - t0_); }
#else
        if constexpr (!Epi::AFTER_DRAIN) { E(acc, cur, wr, wc, fr, fq); S.done(cur); }
#endif
        if (!has_next) break;
#pragma unroll
        for (int a = 0; a < 2; ++a)
#pragma unroll
            for (int b = 0; b < 2; ++b)
#pragma unroll
                for (int m = 0; m < 4; ++m)
#pragma unroll
                    for (int n = 0; n < 2; ++n) acc[a][b][m][n] = (f32x4){0.f, 0.f, 0.f, 0.f};
        cur = nxt; cA = nA; cB = nB; ++ui;
        if constexpr (ALIGN_EPI) { if (wr == 1) PG8_BAR; }
    }
    PG8_WAIT_V(0);
    if constexpr (!ALIGN_EPI) { if (wr == 0) PG8_BAR; }
    PG8_BAR;
    if constexpr (Epi::AFTER_DRAIN) { E.fused(acc, cur, wr, wc, fr, fq, lds, wid, lane); S.done(cur); }
#undef PG8_SA
#undef PG8_SB
#undef PG8_STAGE
#undef PG8_LDA
#undef PG8_LDB
#undef PG8_MMA
#undef PG8_WAIT_V
#undef PG8_WAIT_L
#undef PG8_BAR
#undef PG8_SCHED
}
}

#ifndef PG8_SP2
#define PG8_SP2 true
#endif
#ifndef PG8_ALIGN
#define PG8_ALIGN true
#endif
#ifndef MK_PER_PHASE
#define MK_PER_PHASE 0
#endif

constexpr int NWAVES = 8;
constexpr int BATCH = 2, SEQ = 8192, DM = 1024, DEPTH = 2, NH = 8, HD = 128, NBLK = 32, MOBA = 256, CK = 31;
constexpr int M = BATCH * SEQ;
constexpr int N_IN = 9216;
constexpr float EPS = 1e-6f;
constexpr float QSCALE = 0.08838834764831845f * 1.4426950408889634f;
constexpr int NPHASE_L = 10, NPHASES = NPHASE_L * DEPTH;

constexpr size_t MiB = 1u << 20;
constexpr size_t WS_CTL = 0, CTL_ZERO_BYTES = 65536;
constexpr size_t WS_ROPE = 1 * MiB;
constexpr size_t WS_KMEAN = 2 * MiB;
constexpr size_t WS_LPART = 2 * MiB + 512 * 1024;
constexpr size_t WS_WT = 4 * MiB;
constexpr size_t WT_B = 0, WT_C = 3072, WT_A = 5120, WT_PA = 9216, WT_PC = 10240, WT_O = 11264, WT_ROWS = 12288;
constexpr size_t WS_XN = 28 * MiB;
constexpr size_t WS_Q = 60 * MiB, WS_K = 92 * MiB, WS_V = 124 * MiB;
constexpr size_t WS_LIST = 156 * MiB;
constexpr size_t WS_PART = 172 * MiB;
constexpr size_t WS_GA = 92 * MiB, WS_GLU = 124 * MiB, WS_SZC = 156 * MiB, WS_GC = 188 * MiB, WS_AC = 220 * MiB  , WS_SS = 284 * MiB  , WS_WO1 = 285 * MiB  , WS_END = 287 * MiB;
constexpr size_t WS_MB = WS_Q;
constexpr int CW_BAR = 1024;
constexpr int CW_CNT = 8192;
static_assert((CW_CNT + DEPTH * 512) * 4 <= (int)CTL_ZERO_BYTES && CW_BAR + 3456 <= CW_CNT, "CTL map");

constexpr int RING_OFF = 0, RING_BYTES = 131072;
constexpr int LDSCTL_OFF = RING_BYTES, MISC_OFF = LDSCTL_OFF + 320;
constexpr int XTRA_OFF = RING_BYTES + 512;
constexpr int STG_OFF = XTRA_OFF + 8192;
constexpr int LDS_BYTES = 163840;
constexpr int RSTD_OFF = STG_OFF + 2048;
constexpr int RTAB_OFF = RSTD_OFF + 16384;
static_assert(RTAB_OFF + 1024 <= LDS_BYTES, "LDS map");
static_assert(STG_OFF + 8 * 2176 <= LDS_BYTES, "LDS map");
#define GAS __attribute__((address_space(1)))
#define LAS __attribute__((address_space(3)))
typedef unsigned short bf16;
typedef unsigned v4u __attribute__((ext_vector_type(4)));
typedef float f32x4 __attribute__((ext_vector_type(4)));
typedef short bf16x8 __attribute__((ext_vector_type(8)));
typedef GAS unsigned gu32;
typedef GAS unsigned long long gu64;
#define RLX_AGENT __ATOMIC_RELAXED, __HIP_MEMORY_SCOPE_AGENT
#define LDS_WAIT() asm volatile("s_waitcnt lgkmcnt(0)" ::: "memory")
#define VM_WAIT() asm volatile("s_waitcnt vmcnt(0)" ::: "memory")
__device__ __forceinline__ unsigned long long rt() { return __builtin_amdgcn_s_memrealtime(); }
__device__ __forceinline__ unsigned f2bf(float f) { unsigned u = __builtin_bit_cast(unsigned, f); return (u + 0x7fffu + ((u >> 16) & 1u)) >> 16; }
__device__ __forceinline__ unsigned pk2(float lo, float hi) { return f2bf(lo) | (f2bf(hi) << 16); }

#define XB_TMO      128
#define XB_XCNT(j)  (256  + 64 * (j))
#define XB_XSUB(j)  (1280 + 64 * (j))
#define XB_XGEN(j)  (2304 + 64 * (j))
#define XB_TOP      3328
#define XB_TOPGEN   3392
#define XCD_BAR_WORDS 3456
#define XB_SPIN_CAP (1u << 18)

__device__ __forceinline__ unsigned xb_ld(unsigned* p)              { return __hip_atomic_load(p, __ATOMIC_RELAXED, __HIP_MEMORY_SCOPE_AGENT); }
__device__ __forceinline__ unsigned xb_add(unsigned* p, unsigned v) { return __hip_atomic_fetch_add(p, v, __ATOMIC_RELAXED, __HIP_MEMORY_SCOPE_AGENT); }
__device__ __forceinline__ unsigned xb_xcc_id() { return (unsigned)__builtin_amdgcn_s_getreg((3 << 11) | 20) & 0xFu; }
#define XB_SPIN(cond, bar) do { unsigned _sp = 0; while (cond) { __builtin_amdgcn_s_sleep(1); \
    if ((++_sp & 255u) == 0u) { if (xb_ld(&(bar)[XB_TMO])) break; if (_sp > XB_SPIN_CAP) { atomicAdd(&(bar)[XB_TMO], 1u); break; } } } } while (0)

struct XcdBarrier {
    unsigned* bar; unsigned x;
    volatile LAS unsigned* st;
};

__device__ __forceinline__ XcdBarrier xcd_barrier_post(unsigned* bar, volatile LAS unsigned* st) {
    XcdBarrier b; b.bar = bar; b.x = xb_xcc_id(); b.st = st;
    if (threadIdx.x == 0) (void)xb_add(&bar[XB_XCNT(b.x)], 1u);
    return b;
}
__device__ __forceinline__ void xcd_barrier_complete(unsigned* bar, unsigned x, unsigned& nloc, unsigned& nx) {
    const unsigned G = gridDim.x * gridDim.y * gridDim.z;
    unsigned sum, cnt, mine, sp = 0u;
    for (;;) {
        sum = 0u; cnt = 0u; mine = 0u;
#pragma unroll
        for (unsigned j = 0; j < 16; ++j) { const unsigned c = xb_ld(&bar[XB_XCNT(j)]); sum += c; cnt += (c > 0u) ? 1u : 0u; mine = (j == x) ? c : mine; }
        if (sum == G) break;
        __builtin_amdgcn_s_sleep(1);
        if ((++sp & 255u) == 0u) { if (xb_ld(&bar[XB_TMO])) break; if (sp > XB_SPIN_CAP) { atomicAdd(&bar[XB_TMO], 1u); break; } }
    }
    nloc = mine > 0u ? mine : 1u; nx = cnt > 0u ? cnt : 1u;
}

__device__ __forceinline__ void xcd_barrier(const XcdBarrier& b) {
    asm volatile("s_waitcnt vmcnt(0)" ::: "memory");
    __syncthreads();
    if (threadIdx.x == 0) {
        GAS unsigned* bar_g = (GAS unsigned*)b.bar; unsigned bx_ = b.x;
        asm volatile("" : "+s"(bar_g), "+s"(bx_)); unsigned* bar = (unsigned*)bar_g;
        __builtin_amdgcn_s_waitcnt(0);
        unsigned nloc = b.st[0], nx = b.st[1];
        if (nloc == 0u) { xcd_barrier_complete(bar, bx_, nloc, nx); b.st[0] = nloc; b.st[1] = nx; }
        const unsigned old = xb_add(&bar[XB_XSUB(bx_)], 1u);
        const unsigned gen = old / nloc;
        if (old + 1u == (gen + 1u) * nloc) {
            __builtin_amdgcn_fence(__ATOMIC_RELEASE, "agent");
            asm volatile("s_waitcnt vmcnt(0)" ::: "memory");
            const unsigned og = xb_add(&bar[XB_TOP], 1u);
            const unsigned tg = og / nx;
            if (og + 1u == (tg + 1u) * nx) xb_add(&bar[XB_TOPGEN], 1u);
            else XB_SPIN(xb_ld(&bar[XB_TOPGEN]) == tg, bar);
            __builtin_amdgcn_fence(__ATOMIC_ACQUIRE, "agent");
            xb_add(&bar[XB_XGEN(bx_)], 1u);
            asm volatile("s_waitcnt vmcnt(0)" ::: "memory");
        } else {
            XB_SPIN(xb_ld(&bar[XB_XGEN(bx_)]) == gen, bar);
            __builtin_amdgcn_fence(__ATOMIC_ACQUIRE, "agent");
            asm volatile("s_waitcnt vmcnt(0)" ::: "memory");
        }
    }
    __syncthreads();
}

typedef float f32x16 __attribute__((ext_vector_type(16)));
typedef short v4i16_t __attribute__((ext_vector_type(4)));
typedef float f32x2v __attribute__((ext_vector_type(2)));
struct Frame {
    LAS unsigned char* lds;
    volatile LAS unsigned* MISC;
    gu32* ctl;
    int tid, lane, wave;
    int vcu, G;
    unsigned char* ws;
    unsigned long long pacc, pt0;
};
#ifndef PROBE_PHASE
#define PROBE_PHASE -1
#endif
#define PSUB_BEGIN(code) do { if (PROBE_PHASE == (code)) { __builtin_amdgcn_sched_barrier(0); F.pt0 = rt(); __builtin_amdgcn_sched_barrier(0); } } while (0)
#define PSUB_END(code) do { if (PROBE_PHASE == (code)) { __builtin_amdgcn_sched_barrier(0); F.pacc += rt() - F.pt0; __builtin_amdgcn_sched_barrier(0); } } while (0)
struct Args { const float* in[13]; float* out; unsigned char* ws; int ph_lo, ph_hi; };
#define KARG ((const volatile __attribute__((address_space(4))) Args*)__builtin_amdgcn_kernarg_segment_ptr())
#define ARG_IN(i) ((const float*)KARG->in[i])
#define ARG_OUT ((float*)KARG->out)
__device__ __forceinline__ float wave_sum(float v) {
#pragma unroll
    for (int o = 1; o < 64; o <<= 1) v += __shfl_xor(v, o);
    return v;
}
__device__ __forceinline__ float wave_max(float v) {
#pragma unroll
    for (int o = 1; o < 64; o <<= 1) v = fmaxf(v, __shfl_xor(v, o));
    return v;
}
using pg8::cvt_pk_bf16; using pg8::bf_lo; using pg8::bf_hi; using pg8::sigm; using pg8::silu;

__device__ __forceinline__ void p0_transpose_item(const float* W, int ldw, int src_col0, bf16* WT, int dst_row0, int dpitch, int dk0, int k0, LAS float* scr, int lane) {
    f32x4 wv[16];
    const float* src = W + (size_t)(k0 + (lane >> 4)) * ldw + src_col0 + 4 * (lane & 15);
#pragma unroll
    for (int i = 0; i < 16; ++i) wv[i] = __builtin_nontemporal_load((const GAS f32x4*)(src + (size_t)(4 * i) * ldw));
#pragma unroll
    for (int i = 0; i < 16; ++i) { const int kk = 4 * i + (lane >> 4), n0 = 4 * (lane & 15), sw = kk & 31; LAS float* d = scr + kk * 64;
        d[(n0 + 0) ^ sw] = wv[i].x; d[(n0 + 1) ^ sw] = wv[i].y; d[(n0 + 2) ^ sw] = wv[i].z; d[(n0 + 3) ^ sw] = wv[i].w; }
    LDS_WAIT(); asm volatile("" ::: "memory");
    const int c = lane & 7;
#pragma unroll
    for (int j = 0; j < 8; ++j) { const int n = (lane >> 3) + 8 * j; float t[8];
#pragma unroll
        for (int q = 0; q < 8; ++q) { const int kk = 8 * c + q; t[q] = scr[kk * 64 + (n ^ (kk & 31))]; }
        v4u o; o.x = pk2(t[0], t[1]); o.y = pk2(t[2], t[3]); o.z = pk2(t[4], t[5]); o.w = pk2(t[6], t[7]);
        *(GAS v4u*)(WT + (size_t)(dst_row0 + n) * dpitch + dk0 + k0 + 8 * c) = o; }
    LDS_WAIT(); asm volatile("" ::: "memory");
}
__device__ __forceinline__ void ph0_prologue(Frame& F, int l, const float* xin) {
    LAS float* scr = (LAS float*)(F.lds + RING_OFF + F.wave * 16384);
    const int gw = F.vcu * NWAVES + F.wave, NGW = F.G * NWAVES;
    bf16* WT = (bf16*)(F.ws + WS_WT);
    const float* w_in = ARG_IN(2) + (size_t)l * DM * N_IN;
    const float* w_pa = ARG_IN(10) + (size_t)l * DM * DM; const float* w_pc = ARG_IN(11) + (size_t)l * DM * DM; const float* w_o = ARG_IN(12) + (size_t)l * DM * DM;
    PSUB_BEGIN(300);
    constexpr int NRB = WT_ROWS / 64, NITEMS = NRB * (DM / 64);
    for (int it = gw; it < NITEMS; it += NGW) {
        const int rb = it % NRB, kb = it / NRB, r = rb * 64;
        const float* W; int ldw, src, drow = r, dpitch = DM, dk0 = 0;
        if (r < (int)WT_C) { W = w_in; ldw = N_IN; src = r; }
        else if (r < (int)WT_A) { const int q = r - (int)WT_C; W = w_in; ldw = N_IN; src = q < 1024 ? 3072 + q : 7168 + (q - 1024); }
        else if (r < (int)WT_PA) { const int q = r - (int)WT_A; W = w_in; ldw = N_IN;
            if (q < 2048) { const int pn = q >> 8, bj = (q >> 7) & 1, i = q & 127; src = 4096 + 1024 * bj + 128 * pn + i; }
            else if (q < 3072) src = 6144 + (q - 2048);
            else src = 8192 + (q - 3072); }
        else if (r < (int)WT_O) {
            const int q = r - (int)WT_PA, half = q >> 10; W = half ? w_pc : w_pa; ldw = DM; src = q & 1023;
            WT = (bf16*)(F.ws + WS_WT) + WT_PA * DM; drow = q & 1023; dpitch = 2 * DM; dk0 = half * DM; }
        else { W = w_o; ldw = DM; src = r - (int)WT_O; if (l == 1) { WT = (bf16*)(F.ws + WS_WO1); drow = r - (int)WT_O; } }
        p0_transpose_item(W, ldw, src, WT, drow, dpitch, dk0, kb * 64, scr, F.lane);
        WT = (bf16*)(F.ws + WS_WT);
    }
    PSUB_END(300); PSUB_BEGIN(301);
    if (l == 0) {
        const float* g = ARG_IN(1); bf16* XN = (bf16*)(F.ws + WS_XN); float* SS = (float*)(F.ws + WS_SS);
        f32x4 gv[4];
#pragma unroll
        for (int j = 0; j < 4; ++j) gv[j] = ((const GAS f32x4*)g)[F.lane + 64 * j];
        for (int m = gw; m < M; m += 2 * NGW) {
            const int m2 = m + NGW;
            const GAS f32x4* xr = (const GAS f32x4*)(xin + (size_t)m * DM) + F.lane; const GAS f32x4* xr2 = (const GAS f32x4*)(xin + (size_t)m2 * DM) + F.lane;
            f32x4 v[4], v2[4]; float s = 0.f, s2 = 0.f;
#pragma unroll
            for (int j = 0; j < 4; ++j) { v[j] = xr[64 * j]; v2[j] = xr2[64 * j]; }
#pragma unroll
            for (int j = 0; j < 4; ++j) { s += (v[j].x * v[j].x + v[j].y * v[j].y) + (v[j].z * v[j].z + v[j].w * v[j].w); s2 += (v2[j].x * v2[j].x + v2[j].y * v2[j].y) + (v2[j].z * v2[j].z + v2[j].w * v2[j].w); }
            s = wave_sum(s); s2 = wave_sum(s2);
            if (F.lane < 16) { SS[(size_t)m * 16 + F.lane] = F.lane == 0 ? s : 0.f; SS[(size_t)m2 * 16 + F.lane] = F.lane == 0 ? s2 : 0.f; }
            GAS unsigned long long* o8 = (GAS unsigned long long*)(XN + (size_t)m * DM) + F.lane; GAS unsigned long long* o82 = (GAS unsigned long long*)(XN + (size_t)m2 * DM) + F.lane;
#pragma unroll
            for (int j = 0; j < 4; ++j) { const f32x4 y = v[j] * gv[j]; o8[64 * j] = (unsigned long long)cvt_pk_bf16(y.x, y.y) | ((unsigned long long)cvt_pk_bf16(y.z, y.w) << 32);
                const f32x4 y2 = v2[j] * gv[j]; o82[64 * j] = (unsigned long long)cvt_pk_bf16(y2.x, y2.y) | ((unsigned long long)cvt_pk_bf16(y2.z, y2.w) << 32); }
        }
    }
    PSUB_END(301);
    if (blockIdx.x == 0) { gu32* cnt = F.ctl + CW_CNT + l * 512; cnt[F.tid] = 0u; }
    if (l == 0) {
        _Float16* rt16 = (_Float16*)(F.ws + WS_ROPE);
        constexpr float IF[16] = {1.000000000e+00f, 4.403665960e-01f, 1.939227432e-01f, 8.539710194e-02f, 3.760603070e-02f, 1.656044088e-02f, 7.292664610e-03f, 3.211446106e-03f,
                                  1.414213562e-03f, 6.227724371e-04f, 2.742481884e-04f, 1.207697351e-04f, 5.318295734e-05f, 2.341999971e-05f, 1.031338525e-05f, 4.541670478e-06f};
        for (int t = (F.vcu * NWAVES + F.wave) * 64 + F.lane; t < SEQ; t += NGW * 64) {
#pragma unroll
            for (int i = 0; i < 16; ++i) { float sn, cs; sincosf((float)t * IF[i], &sn, &cs); rt16[t * 32 + i] = (_Float16)cs; rt16[t * 32 + 16 + i] = (_Float16)sn; }
        }
    }
}

__device__ __forceinline__ int prefetch_ss_panel(Frame& F, int N) {
    int bx = blockIdx.x; asm volatile("" : "+s"(bx));
    pg8::StaticOrder S; S.init(M, N, F.G, bx); pg8::Unit u; if (!S.next(0, u)) return -1;
    const char* src = (const char*)(F.ws + WS_SS) + (size_t)u.pm * 256 * 64;
#pragma unroll
    for (int i = 0; i < 2; ++i) { const int p = F.wave * 2 + i;
        __builtin_amdgcn_global_load_lds((const GAS unsigned*)(src + p * 1024 + F.lane * 16), (LAS unsigned*)(F.lds + RSTD_OFF + p * 1024), 16, 0, 0); }
    if (F.tid == 0) { LAS int* w = (LAS int*)(F.lds + MISC_OFF + 80); int neg = -1; asm volatile("" : "+v"(neg)); w[0] = u.pm; w[1] = neg; }
    return u.pm;
}
__device__ __forceinline__ void ph3_gate(Frame& F, int l) {
    const float* kmean = (const float*)(F.ws + WS_KMEAN);
    const bf16* Q = (const bf16*)(F.ws + WS_Q);
    gu32* cnt = F.ctl + CW_CNT + l * 512; unsigned* list = (unsigned*)(F.ws + WS_LIST);
    const int lane = F.lane, r32 = lane & 31, hh = lane >> 5;
    LAS int* hist = (LAS int*)(F.lds + XTRA_OFF); LAS int* base = hist + 64;
    LAS float* kml = (LAS float*)(F.lds + RING_OFF);
    for (int it0 = F.vcu; it0 < BATCH * NH * NBLK; it0 += 2 * F.G) {
        f32x16 p[2]; int bqv[2], bhv[2], tv[2]; bool act[2];
        __syncthreads();
#pragma unroll
        for (int i = 0; i < 2; ++i) { const int it = it0 + i * F.G; const bool a_ = it < BATCH * NH * NBLK && (it & 31) != 0; const int bh = (a_ ? it : 1) >> 5;
            const int row = F.tid >> 4, c = F.tid & 15; const float* src = kmean + ((size_t)bh * NBLK + row) * HD + 8 * c;
            const f32x4 v0 = *(const GAS f32x4*)src, v1 = *(const GAS f32x4*)(src + 4);
            LAS float* d = kml + i * (NBLK * 132) + row * 132 + 8 * c; *(LAS f32x4*)d = v0; *(LAS f32x4*)(d + 4) = v1; }
        __syncthreads();
#pragma unroll
        for (int i = 0; i < 2; ++i) {
            const int it = it0 + i * F.G; act[i] = it < BATCH * NH * NBLK && (it & 31) != 0;
            const int itc = act[i] ? it : 1;
            const int bq = itc & 31, bh = itc >> 5, b = bh >> 3, h = bh & 7;
            bqv[i] = bq; bhv[i] = bh; tv[i] = bq * MOBA + F.wave * 32 + r32;
            const bf16* qrow = Q + ((size_t)b * SEQ + tv[i]) * DM + h * HD;
            const LAS float* kmr = kml + i * (NBLK * 132) + r32 * 132;
            p[i] = (f32x16){0.f, 0.f, 0.f, 0.f, 0.f, 0.f, 0.f, 0.f, 0.f, 0.f, 0.f, 0.f, 0.f, 0.f, 0.f, 0.f};
            if (act[i]) {
#pragma unroll
                for (int ds = 0; ds < 8; ++ds) {
                    const bf16x8 qf = *(const GAS bf16x8*)(qrow + 16 * ds + 8 * hh);
                    const f32x4 k0 = *(const LAS f32x4*)(kmr + 16 * ds + 8 * hh), k1 = *(const LAS f32x4*)(kmr + 16 * ds + 8 * hh + 4);
                    v4u hi, lo;
                    hi.x = cvt_pk_bf16(k0.x, k0.y); hi.y = cvt_pk_bf16(k0.z, k0.w); hi.z = cvt_pk_bf16(k1.x, k1.y); hi.w = cvt_pk_bf16(k1.z, k1.w);
                    lo.x = cvt_pk_bf16(k0.x - bf_lo(hi.x), k0.y - bf_hi(hi.x)); lo.y = cvt_pk_bf16(k0.z - bf_lo(hi.y), k0.w - bf_hi(hi.y));
                    lo.z = cvt_pk_bf16(k1.x - bf_lo(hi.z), k1.y - bf_hi(hi.z)); lo.w = cvt_pk_bf16(k1.z - bf_lo(hi.w), k1.w - bf_hi(hi.w));
                    p[i] = __builtin_amdgcn_mfma_f32_32x32x16_bf16(__builtin_bit_cast(bf16x8, hi), qf, p[i], 0, 0, 0);
                    p[i] = __builtin_amdgcn_mfma_f32_32x32x16_bf16(__builtin_bit_cast(bf16x8, lo), qf, p[i], 0, 0, 0);
                }
            }
#pragma unroll
            for (int r = 0; r < 16; ++r) if ((r & 3) + 8 * (r >> 2) + 4 * hh >= bq) p[i][r] = -INFINITY;
        }
        __syncthreads();
        if (F.tid < 64) hist[F.tid] = 0;
        __syncthreads();
        int pn[2][3], pp[2][3];
#pragma unroll
        for (int i = 0; i < 2; ++i) { const int nv = act[i] ? (bqv[i] < 3 ? bqv[i] : 3) : 0;
#pragma unroll
            for (int rk = 0; rk < 3; ++rk) { pn[i][rk] = -1; pp[i][rk] = 0; if (rk < nv) {
                float best = -INFINITY; int bi = 64;
#pragma unroll
                for (int r = 0; r < 16; ++r) { const int n = (r & 3) + 8 * (r >> 2) + 4 * hh; if (p[i][r] > best) { best = p[i][r]; bi = n; } }
                const float ob = __shfl_xor(best, 32); const int oi = __shfl_xor(bi, 32);
                if (ob > best || (ob == best && oi < bi)) { best = ob; bi = oi; }
#pragma unroll
                for (int r = 0; r < 16; ++r) if ((r & 3) + 8 * (r >> 2) + 4 * hh == bi) p[i][r] = -INFINITY;
                pn[i][rk] = bi; if (hh == 0) pp[i][rk] = atomicAdd((int*)(hist + i * 32 + bi), 1); } } }
        __syncthreads();
        if (F.tid < 64) { const int i = F.tid >> 5, n = F.tid & 31; const int c = hist[F.tid]; const int bh = i ? bhv[1] : bhv[0];
            base[F.tid] = c ? (int)__hip_atomic_fetch_add(cnt + bh * NBLK + n, (unsigned)c, RLX_AGENT) : 0; }
        __syncthreads();
        if (hh == 0) {
#pragma unroll
            for (int i = 0; i < 2; ++i) { const int nv = act[i] ? (bqv[i] < 3 ? bqv[i] : 3) : 0;
#pragma unroll
                for (int rk = 0; rk < 3; ++rk) if (rk < nv) list[(size_t)(bhv[i] * NBLK + pn[i][rk]) * SEQ + base[i * 32 + pn[i][rk]] + pp[i][rk]] = (unsigned)tv[i] | ((unsigned)rk << 13); }
        }
    }
}

__device__ __forceinline__ int koff(int r, int c) { return r * 256 + ((c ^ (r & 15)) << 4); }
__device__ __forceinline__ int voff(int r, int c) { return r * 256 + ((((c >> 2) ^ (r & 3)) << 6) | ((c & 3) << 4)); }
__device__ __forceinline__ void load_kv_block(Frame& F, const bf16* K, const bf16* V, size_t row0, int h) {
    LAS unsigned char* lk = F.lds + RING_OFF;
    int lane = F.lane; asm volatile("" : "+v"(lane));
    const int rl = lane >> 4, pos = lane & 15;
    const char* kb = (const char*)(K + row0 * DM + h * HD); const char* vb = (const char*)(V + row0 * DM + h * HD);
#pragma unroll
    for (int i = 0; i < 8; ++i) {
        const int p = F.wave + 8 * i, r = 4 * p + rl;
        const unsigned ksrc = (unsigned)(r * (DM * 2) + ((pos ^ (r & 15)) << 4));
        const unsigned vsrc = (unsigned)(r * (DM * 2) + (((((pos >> 2) ^ (r & 3)) << 2) | (pos & 3)) << 4));
        __builtin_amdgcn_global_load_lds((const GAS unsigned*)(kb + ksrc), (LAS unsigned*)(lk + p * 1024), 16, 0, 0);
        __builtin_amdgcn_global_load_lds((const GAS unsigned*)(vb + vsrc), (LAS unsigned*)(lk + 65536 + p * 1024), 16, 0, 0);
    }
    asm volatile("s_waitcnt vmcnt(0)" ::: "memory");
    __syncthreads();
}
__device__ __forceinline__ void sm_tile(f32x16& p, bool dg, int hh, int r32, float& ls, bf16x8& pa0, bf16x8& pa1) {
#pragma unroll
    for (int r = 0; r < 16; ++r) { float e = __builtin_amdgcn_exp2f(p[r]); if (dg && ((r & 3) + 8 * (r >> 2) + 4 * hh) > r32) e = 0.f; p[r] = e; ls += e; }
    v4u pw0, pw1;
    pw0.x = cvt_pk_bf16(p[0], p[1]); pw0.y = cvt_pk_bf16(p[2], p[3]); pw0.z = cvt_pk_bf16(p[4], p[5]); pw0.w = cvt_pk_bf16(p[6], p[7]);
    pw1.x = cvt_pk_bf16(p[8], p[9]); pw1.y = cvt_pk_bf16(p[10], p[11]); pw1.z = cvt_pk_bf16(p[12], p[13]); pw1.w = cvt_pk_bf16(p[14], p[15]);
    pa0 = __builtin_bit_cast(bf16x8, pw0); pa1 = __builtin_bit_cast(bf16x8, pw1);
}
template <bool DIAG, bool OT>
__device__ __forceinline__ void attn_core(LAS unsigned char* lds, const bf16x8 (&qf)[8], int ntiles, f32x16 (&o)[4], float& ls, int lane) {
    const int r32 = lane & 31, hh = lane >> 5;
    const int kbase = r32 * 256, kx = r32 & 15;
    const int q_ = (lane & 15) >> 2, p_ = lane & 3, g1 = (lane >> 4) & 1;
    int vb[4];
#pragma unroll
    for (int d = 0; d < 4; ++d) vb[d] = 65536 + (4 * hh + q_) * 256 + ((d ^ q_) << 6) + 32 * g1 + 8 * p_;
#define SB() __builtin_amdgcn_sched_barrier(0)
#define LOADK(KT) { const LAS unsigned char* kp_ = lds + (KT) * 8192 + kbase; _Pragma("unroll") for (int ds = 0; ds < 8; ++ds) kf[ds] = *(const LAS bf16x8*)(kp_ + (((2 * ds + hh) ^ kx) << 4)); }
#define QKM(P) { P = (f32x16){0.f, 0.f, 0.f, 0.f, 0.f, 0.f, 0.f, 0.f, 0.f, 0.f, 0.f, 0.f, 0.f, 0.f, 0.f, 0.f}; _Pragma("unroll") for (int ds = 0; ds < 8; ++ds) P = __builtin_amdgcn_mfma_f32_32x32x16_bf16(kf[ds], qf[ds], P, 0, 0, 0); }
#define LOADV(VF, KT, D0) { _Pragma("unroll") for (int dd = 0; dd < 2; ++dd) _Pragma("unroll") for (int s2 = 0; s2 < 2; ++s2) { const LAS unsigned char* vp_ = lds + (KT) * 8192 + vb[(D0) + dd] + s2 * 4096; \
        const v4i16_t lo_ = __builtin_amdgcn_ds_read_tr16_b64_v4i16((LAS v4i16_t*)vp_); const v4i16_t hi_ = __builtin_amdgcn_ds_read_tr16_b64_v4i16((LAS v4i16_t*)(vp_ + 2048)); \
        VF[dd * 2 + s2] = (bf16x8){lo_[0], lo_[1], lo_[2], lo_[3], hi_[0], hi_[1], hi_[2], hi_[3]}; } }
#define PVM(VF, D0) { _Pragma("unroll") for (int dd = 0; dd < 2; ++dd) { o[(D0) + dd] = __builtin_amdgcn_mfma_f32_32x32x16_bf16(OT ? VF[dd * 2] : pa0, OT ? pa0 : VF[dd * 2], o[(D0) + dd], 0, 0, 0); o[(D0) + dd] = __builtin_amdgcn_mfma_f32_32x32x16_bf16(OT ? VF[dd * 2 + 1] : pa1, OT ? pa1 : VF[dd * 2 + 1], o[(D0) + dd], 0, 0, 0); } }
    bf16x8 kf[8];
    LOADK(0)
    f32x16 pn; QKM(pn)
    if (ntiles > 1) LOADK(1)
    for (int kt = 0; kt < ntiles; ++kt) {
        const bool last = kt + 1 >= ntiles;
        f32x16 p = pn;
        bf16x8 va[4], vc[4], pa0, pa1;
        LOADV(va, kt, 0)
        SB();
        if (!last) QKM(pn)
        sm_tile(p, DIAG && last, hh, r32, ls, pa0, pa1);
        LOADV(vc, kt, 2)
        SB();
        PVM(va, 0)
        if (kt + 2 < ntiles) LOADK(kt + 2)
        SB();
        PVM(vc, 2)
    }
#undef SB
#undef LOADK
#undef QKM
#undef LOADV
#undef PVM
}
constexpr int STG_ROW = 272, STG_WAVE = 8 * STG_ROW;
__device__ __forceinline__ void stage_round(LAS unsigned char* stg, const f32x16 (&o)[4], int k, int lane, v4u (&pc)[2]) {
    const int r32 = lane & 31, hh = lane >> 5;
#pragma unroll
    for (int rr = 0; rr < 4; ++rr)
#pragma unroll
        for (int d = 0; d < 4; ++d) *(LAS unsigned short*)(stg + (rr + 4 * hh) * STG_ROW + (32 * d + r32) * 2) = (unsigned short)(cvt_pk_bf16(o[d][4 * k + rr], 0.f) & 0xffffu);
    LDS_WAIT(); asm volatile("" ::: "memory");
#pragma unroll
    for (int j = 0; j < 2; ++j) { const int sl = lane + 64 * j; pc[j] = *(const LAS v4u*)(stg + (sl >> 4) * STG_ROW + (sl & 15) * 16); }
    LDS_WAIT(); asm volatile("" ::: "memory");
}
__device__ __forceinline__ void ph4_sparse(Frame& F, int l) {
    const bf16* Q = (const bf16*)(F.ws + WS_Q); const bf16* K = (const bf16*)(F.ws + WS_K); const bf16* V = (const bf16*)(F.ws + WS_V);
    bf16* PART = (bf16*)(F.ws + WS_PART); float* LP = (float*)(F.ws + WS_LPART);
    const unsigned* list = (const unsigned*)(F.ws + WS_LIST); gu32* cnt = F.ctl + CW_CNT + l * 512;
    LAS int* pre = (LAS int*)(F.lds + XTRA_OFF);
    LAS unsigned* ent = (LAS unsigned*)(F.lds + XTRA_OFF + 4096) + F.wave * 32;
    const int lane = F.lane, r32 = lane & 31, hh = lane >> 5;
    constexpr int LOADW = 5;
    const int myc = (int)__hip_atomic_load(cnt + F.tid, RLX_AGENT);
    { int v = myc ? LOADW + 8 * ((myc + 255) >> 8) : 0;
#pragma unroll
      for (int off = 1; off < 64; off <<= 1) { const int t = __shfl_up(v, off); if (lane >= off) v += t; }
      LAS int* wsum = pre + 512;
      if (lane == 63) wsum[F.wave] = v;
      __syncthreads();
      int base = 0;
#pragma unroll
      for (int w = 0; w < NWAVES - 1; ++w) base += (w < F.wave) ? wsum[w] : 0;
      pre[F.tid] = v + base;
      __syncthreads(); }
    const int T = pre[511];
    const int lo = (int)(((long)F.vcu * T) / F.G), hi = (int)(((long)(F.vcu + 1) * T) / F.G);
    LAS unsigned char* stg = F.lds + STG_OFF + F.wave * STG_WAVE;
    int it = lo;
    while (it < hi) {
        int a = 0, bnd = 511;
        while (a < bnd) { const int mid = (a + bnd) >> 1; if (pre[mid] > it) bnd = mid; else a = mid + 1; }
        const int bhn = a, first = bhn ? pre[bhn - 1] : 0, cost = pre[bhn] - first, R = (cost - LOADW) >> 3;
        const int pa = it - first, pb = (hi < pre[bhn] ? hi : pre[bhn]) - first;
        it = first + pb;
        int ra = (pa - LOADW + 7) >> 3; ra = ra < 0 ? 0 : ra; int rb = (pb - LOADW + 7) >> 3; rb = rb < 0 ? 0 : (rb > R ? R : rb);
        if (pb == cost) rb = R;
        if (rb <= ra) continue;
        const int bh = bhn >> 5, n = bhn & 31, b = bh >> 3, h = bh & 7;
        const int c_tot = (int)__hip_atomic_load(cnt + bhn, RLX_AGENT);
        PSUB_BEGIN(200);
        __syncthreads();
        load_kv_block(F, K, V, (size_t)b * SEQ + n * MOBA, h);
        PSUB_END(200);
        const int s1 = (c_tot + 31) >> 5;
        const int send = 8 * rb < s1 ? 8 * rb : s1;
        const unsigned* lst = list + (size_t)bhn * SEQ;
        const bf16* Qh = Q + (size_t)b * SEQ * DM + h * HD + 8 * hh;
        for (int sc = 8 * ra + F.wave; sc < send; sc += NWAVES) {
            const int idx = sc * 32 + r32;
            const unsigned e = idx < c_tot ? lst[idx] : 0xffffffffu;
            const bool valid = e != 0xffffffffu;
            const size_t qr = valid ? (e & 8191u) : 0u;
            bf16x8 qf[8];
#pragma unroll
            for (int ds = 0; ds < 8; ++ds) qf[ds] = *(const GAS bf16x8*)(Qh + qr * DM + 16 * ds);
            f32x16 o[4];
#pragma unroll
            for (int d = 0; d < 4; ++d)
#pragma unroll
                for (int r = 0; r < 16; ++r) o[d][r] = 0.f;
            float ls = 0.f;
            PSUB_BEGIN(202);
            attn_core<false, true>(F.lds + RING_OFF, qf, 8, o, ls, lane);
            PSUB_END(202); PSUB_BEGIN(203);
            ls += __shfl_xor(ls, 32);
            if (valid && hh == 0) LP[((size_t)(e >> 13) * M + (size_t)b * SEQ + qr) * NH + h] = ls;
            char* prow = (char*)(PART + ((size_t)(valid ? (e >> 13) : 0u) * M + (size_t)b * SEQ + qr) * DM + h * HD) + 16 * hh;
#pragma unroll
            for (int d = 0; d < 4; ++d)
#pragma unroll
                for (int jj = 0; jj < 2; ++jj) {
                    unsigned ax = cvt_pk_bf16(o[d][8 * jj + 0], o[d][8 * jj + 1]), ay = cvt_pk_bf16(o[d][8 * jj + 2], o[d][8 * jj + 3]);
                    unsigned bx = cvt_pk_bf16(o[d][8 * jj + 4], o[d][8 * jj + 5]), by = cvt_pk_bf16(o[d][8 * jj + 6], o[d][8 * jj + 7]);
                    { auto r = __builtin_amdgcn_permlane32_swap(ax, bx, false, false); ax = r[0]; bx = r[1]; }
                    { auto r = __builtin_amdgcn_permlane32_swap(ay, by, false, false); ay = r[0]; by = r[1]; }
                    if (valid) *(GAS v4u*)(prow + 32 * (2 * d + jj)) = (v4u){ax, ay, bx, by};
                }
            PSUB_END(203);
        }
    }
}

__device__ __forceinline__ void ph5_diag(Frame& F, int l, int own_pm, int own_hp) {
    bf16* Q = (bf16*)(F.ws + WS_Q); const bf16* K = (const bf16*)(F.ws + WS_K); const bf16* V = (const bf16*)(F.ws + WS_V);
    const bf16* PART = (const bf16*)(F.ws + WS_PART); const float* LP = (const float*)(F.ws + WS_LPART);
    LAS float* lsh = (LAS float*)(F.lds + XTRA_OFF) + F.wave * 32;
    LAS unsigned char* stg = F.lds + STG_OFF + F.wave * STG_WAVE;
    const int it_beg = own_pm >= 0 ? (((own_pm >> 5) * NH + 2 * own_hp) * NBLK + (own_pm & 31)) : F.vcu, it_step = own_pm >= 0 ? NBLK : F.G, it_end = own_pm >= 0 ? it_beg + 2 * NBLK : BATCH * NH * NBLK;
    for (int it = it_beg; it < it_end; it += it_step) {
        int lane = F.lane; asm volatile("" : "+v"(lane));
        const int r32 = lane & 31, hh = lane >> 5;
        const int bq = it & 31, bh = it >> 5, b = bh >> 3, h = bh & 7;
        const size_t row0 = (size_t)b * SEQ + bq * MOBA;
        const int sb = F.wave < 4 ? 7 - F.wave : F.wave - 4;
        const size_t qrow = row0 + sb * 32 + r32;
        bf16x8 qf[8];
#pragma unroll
        for (int ds = 0; ds < 8; ++ds) qf[ds] = *(const GAS bf16x8*)(Q + qrow * DM + h * HD + 16 * ds + 8 * hh);
        const int nv = bq < 3 ? bq : 3;
        float lsum_part = 0.f;
        for (int j = 0; j < nv; ++j) lsum_part += LP[((size_t)j * M + qrow) * NH + h];
        PSUB_BEGIN(210);
        __syncthreads();
        load_kv_block(F, K, V, row0, h);
        PSUB_END(210); PSUB_BEGIN(211);
        f32x16 o[4];
#pragma unroll
        for (int d = 0; d < 4; ++d)
#pragma unroll
            for (int r = 0; r < 16; ++r) o[d][r] = 0.f;
        float ls = 0.f;
        attn_core<true, true>(F.lds + RING_OFF, qf, sb + 1, o, ls, lane);
        asm volatile("" ::: "memory"); __builtin_amdgcn_sched_barrier(0);
        PSUB_END(211); PSUB_BEGIN(212);
        const char* prow = (const char*)(PART + qrow * DM + h * HD) + 16 * hh;
        v4u pl[3][8];
#pragma unroll
        for (int s3 = 0; s3 < 3; ++s3)
#pragma unroll
            for (int pc = 0; pc < 8; ++pc) { pl[s3][pc] = (v4u){0u, 0u, 0u, 0u}; if (s3 < nv) pl[s3][pc] = *(const GAS v4u*)(prow + (size_t)s3 * M * DM * 2 + 32 * pc); }
        ls += __shfl_xor(ls, 32);
        ls += lsum_part;
        const float inv = 1.f / ls;
        char* orow = (char*)(Q + qrow * DM + h * HD) + 16 * hh;
#pragma unroll
        for (int d = 0; d < 4; ++d)
#pragma unroll
            for (int jj = 0; jj < 2; ++jj) {
                pg8::f32x4 fa, fb;
#pragma unroll
                for (int i = 0; i < 4; ++i) { const float xa = o[d][8 * jj + i], xb = o[d][8 * jj + 4 + i];
                    auto r = __builtin_amdgcn_permlane32_swap(__float_as_uint(xa), __float_as_uint(xb), false, false);
                    const unsigned r0 = r[0], r1 = r[1]; fa[i] = __uint_as_float(r0); fb[i] = __uint_as_float(r1); }
#pragma unroll
                for (int s3 = 0; s3 < 3; ++s3) { pg8::f32x4 b0, b1; pg8::unpack8(pl[s3][2 * d + jj], b0, b1); fa += b0; fb += b1; }
                *(GAS v4u*)(orow + 32 * (2 * d + jj)) = pg8::pack8(fa * inv, fb * inv);
            }
        PSUB_END(212);
    }
}

__device__ __forceinline__ void ph7_conv(Frame& F, int l) {
    const bf16* GLU = (const bf16*)(F.ws + WS_GLU); const bf16* SZC = (const bf16*)(F.ws + WS_SZC); bf16* C = (bf16*)(F.ws + WS_AC) + DM;
    const float* cw = ARG_IN(6) + (size_t)l * CK * DM; const float* cb = ARG_IN(7) + (size_t)l * DM; const float* cg = ARG_IN(8) + (size_t)l * DM; const float* cbeta = ARG_IN(9) + (size_t)l * DM;
    LAS unsigned* tile = (LAS unsigned*)(F.lds + RING_OFF);
    LAS float* red = (LAS float*)(F.lds + XTRA_OFF);
    LAS float* stat = red + 512;
    const int tid = F.tid, lane = F.lane;
    constexpr int TT = 8;
    float w0[CK], w1[CK];
#pragma unroll
    for (int j = 0; j < CK; ++j) { const f32x2v wv = *(const GAS f32x2v*)(cw + (size_t)j * DM + 2 * tid); w0[j] = wv.x; w1[j] = wv.y; }
    const f32x2v bv = *(const GAS f32x2v*)(cb + 2 * tid), gv = *(const GAS f32x2v*)(cg + 2 * tid), bev = *(const GAS f32x2v*)(cbeta + 2 * tid);
    for (int it = F.vcu; it < M / 32; it += F.G) {
        const int tok0 = it * 32, t0 = tok0 & (SEQ - 1);
        __syncthreads();
        PSUB_BEGIN(100);
        {
            const int zr = t0 < 30 ? 30 - t0 : 0;
            const char* src = (const char*)(GLU + (size_t)(tok0 - 30) * DM);
#pragma unroll 4
            for (int p = F.wave; p < 124; p += NWAVES) {
                if (2 * zr > p) { *(LAS v4u*)((LAS unsigned char*)tile + p * 1024 + lane * 16) = (v4u){0u, 0u, 0u, 0u}; }
                else __builtin_amdgcn_global_load_lds((const GAS unsigned*)(src + (size_t)p * 1024 + lane * 16), (LAS unsigned*)((LAS unsigned char*)tile + p * 1024), 16, 0, 0);
            }
            asm volatile("s_waitcnt vmcnt(0)" ::: "memory");
        }
        __syncthreads();
        PSUB_END(100); PSUB_BEGIN(101);
        float a0[32], a1[32];
#pragma unroll
        for (int hf = 0; hf < 32 / TT; ++hf) {
#pragma unroll
            for (int tt = 0; tt < TT; ++tt) { a0[hf * TT + tt] = bv.x; a1[hf * TT + tt] = bv.y; }
#pragma unroll
            for (int i = 0; i < TT + 30; ++i) { const unsigned w = tile[(hf * TT + i) * 512 + tid]; const float x0 = bf_lo(w), x1 = bf_hi(w);
#pragma unroll
                for (int tt = 0; tt < TT; ++tt) if (i - tt >= 0 && i - tt < CK) { a0[hf * TT + tt] += w0[i - tt] * x0; a1[hf * TT + tt] += w1[i - tt] * x1; }
                if ((i & 7) == 7) __builtin_amdgcn_sched_barrier(0); }
            float rv[2 * TT];
#pragma unroll
            for (int tt = 0; tt < TT; ++tt) { const float p0 = a0[hf * TT + tt], p1 = a1[hf * TT + tt]; rv[2 * tt] = p0 + p1; rv[2 * tt + 1] = p0 * p0 + p1 * p1; }
#define TR_STEP(MM) { const bool up = (lane & (MM)) != 0; _Pragma("unroll") for (int i = 0; i < (MM); ++i) { const float send = up ? rv[i] : rv[i + (MM)], keep = up ? rv[i + (MM)] : rv[i]; rv[i] = keep + __shfl_xor(send, (MM)); } }
            static_assert(TT == 8, "transpose-reduce steps are written out for 16 values");
            TR_STEP(8) TR_STEP(4) TR_STEP(2) TR_STEP(1)
#undef TR_STEP
            rv[0] += __shfl_xor(rv[0], 16); rv[0] += __shfl_xor(rv[0], 32);
            if (lane < 2 * TT) red[F.wave * 64 + hf * 2 * TT + lane] = rv[0];
            __builtin_amdgcn_sched_barrier(0);
        }
        unsigned z[32];
#pragma unroll
        for (int tt = 0; tt < 32; ++tt) z[tt] = *((const GAS unsigned*)(SZC + (size_t)(tok0 + tt) * DM) + tid);
        __syncthreads();
        if (tid < 64) { float s = 0.f;
#pragma unroll
            for (int w = 0; w < 8; ++w) s += red[w * 64 + tid];
            const float other = __shfl_xor(s, 1);
            const float mean = ((tid & 1) ? other : s) * (1.f / DM), ex2 = ((tid & 1) ? s : other) * (1.f / DM);
            const float var = fmaxf(ex2 - mean * mean, 0.f);
            stat[tid] = (tid & 1) ? 1.f / sqrtf(var + EPS) : mean; }
        __syncthreads();
        PSUB_END(101); PSUB_BEGIN(102);
#pragma unroll
        for (int tt = 0; tt < 32; ++tt) {
            const float mean = stat[2 * tt], rstd = stat[2 * tt + 1];
            const float y0 = (a0[tt] - mean) * rstd * gv.x + bev.x, y1 = (a1[tt] - mean) * rstd * gv.y + bev.y;
            *((GAS unsigned*)(C + (size_t)(tok0 + tt) * (2 * DM)) + tid) = cvt_pk_bf16(silu(y0) * bf_lo(z[tt]), silu(y1) * bf_hi(z[tt]));
        }
        PSUB_END(102);
    }
}

#ifndef ONLY_PHASE
#define ONLY_PHASE -1
#endif
#ifndef ONLY_SUB
#define ONLY_SUB 0
#endif
#define SUB(k) (ONLY_SUB == 0 || ONLY_SUB == (k))
#ifndef STAG6
#define STAG6 0u
#endif
#define ONLY(k) (ONLY_PHASE < 0 || ONLY_PHASE == (k))
__global__ void __launch_bounds__(NWAVES * 64, 2) hybrid_fwd(Args args) {
    extern __shared__ __attribute__((aligned(16))) unsigned char lds[];
    Frame F;
    F.lds = (LAS unsigned char*)lds;
    F.MISC = (volatile LAS unsigned*)(F.lds + MISC_OFF);
    F.tid = threadIdx.x; F.lane = F.tid & 63; F.wave = __builtin_amdgcn_readfirstlane(F.tid >> 6);
    F.G = gridDim.x; { const int bx = blockIdx.x; F.vcu = (F.G % 8 == 0) ? (bx % 8) * (F.G / 8) + bx / 8 : bx; }
    F.ws = args.ws; F.ctl = (gu32*)(args.ws + WS_CTL);
    for (int u = F.tid; u < (LDS_BYTES - LDSCTL_OFF) / 4; u += NWAVES * 64) ((LAS unsigned*)(F.lds + LDSCTL_OFF))[u] = 0u;
    __syncthreads();
    XcdBarrier bar; bar.bar = (unsigned*)(F.ctl + CW_BAR); bar.x = 0; bar.st = nullptr;
#if !MK_PER_PHASE
    bar = xcd_barrier_post((unsigned*)(F.ctl + CW_BAR), F.MISC + 8);
#endif
#if MK_PER_PHASE
#define GRID_BAR() do { } while (0)
#else
#define GRID_BAR() xcd_barrier(bar)
#endif
    const int lo = args.ph_lo, hi = args.ph_hi;
    unsigned long long probe_t0 = 0, probe_acc = 0; F.pacc = 0; F.pt0 = 0; unsigned pt32 = 0; unsigned long long clk_t0 = 0, clk_c0 = 0, clk_t = 0, clk_c = 0;
#define WT ((bf16*)(F.ws + WS_WT))
#define XN ((bf16*)(F.ws + WS_XN))
#define Qb ((bf16*)(F.ws + WS_Q))
#define GA ((bf16*)(F.ws + WS_GA))
#define GLU ((bf16*)(F.ws + WS_GLU))
#define SZC ((bf16*)(F.ws + WS_SZC))
#define GC ((bf16*)(F.ws + WS_GC))
#define ACb ((bf16*)(F.ws + WS_AC))
#define MB ((bf16*)(F.ws + WS_MB))
#define PH_BEGIN(k) if (ONLY(k) && lo <= l * NPHASE_L + (k) && l * NPHASE_L + (k) < hi) { { int t_ = threadIdx.x; asm volatile("" : "+v"(t_)); F.tid = t_; F.lane = t_ & 63; F.wave = __builtin_amdgcn_readfirstlane(t_ >> 6); GAS unsigned char* w_ = (GAS unsigned char*)args.ws; asm volatile("" : "+s"(w_)); F.ws = (unsigned char*)w_; F.ctl = (gu32*)(w_ + WS_CTL); } if (PROBE_PHASE == (k)) probe_t0 = rt(); if (PROBE_PHASE == 700 + (k)) pt32 = (unsigned)rt(); if (PROBE_PHASE == 600 + (k)) { clk_t0 = rt(); clk_c0 = __builtin_amdgcn_s_memtime(); }
#define PH_END_NOBAR(k) if (PROBE_PHASE == (k)) { const unsigned long long t1_ = rt(); probe_acc += t1_ - probe_t0; } if (PROBE_PHASE == 600 + (k)) { clk_t += rt() - clk_t0; clk_c += __builtin_amdgcn_s_memtime() - clk_c0; } }
#define PH_END(k) if (PROBE_PHASE == 700 + (k)) { if (F.tid == 0) atomicMax((unsigned*)(F.ctl + 96), (unsigned)rt() - pt32); } if (l * NPHASE_L + (k) + 1 < hi) GRID_BAR(); if (PROBE_PHASE == 500 && l * NPHASE_L + (k) + 1 < hi) GRID_BAR(); if (PROBE_PHASE == (k)) { const unsigned long long t1_ = rt(); probe_acc += t1_ - probe_t0; } if (PROBE_PHASE == 600 + (k)) { clk_t += rt() - clk_t0; clk_c += __builtin_amdgcn_s_memtime() - clk_c0; } }
#pragma unroll 1
    for (int l = 0; l < DEPTH; ++l) {
        PH_BEGIN(0) { ph0_prologue(F, l, (l == 0) ? ARG_IN(0) : (const float*)ARG_OUT); }
        PH_END(0)
        PH_BEGIN(1) { (void)prefetch_ss_panel(F, 3072); pg8::Gemm g{XN, WT + WT_B * DM, M, 3072, DM}; pg8::StaticOrder S; S.init(M, 3072, F.G, (int)blockIdx.x);
            pg8::EpiQKV E{Qb, (size_t)(WS_K - WS_Q) / 2, ARG_IN(4) + (size_t)l * HD, ARG_IN(5) + (size_t)l * HD, (const unsigned short*)(F.ws + WS_ROPE),
                          (float*)(F.ws + WS_KMEAN), QSCALE, F.lds + XTRA_OFF, SEQ, pg8::RowRstd{(LAS float*)(F.lds + RSTD_OFF), (LAS float*)(F.lds + RTAB_OFF), (LAS int*)(F.lds + MISC_OFF + 80), (const float*)(F.ws + WS_SS)}};
            pg8::gemm_phase<pg8::EpiQKV, pg8::StaticOrder, true, PG8_SP2>(F.lds + RING_OFF, g, S, E); }
        PH_END(1)
        PH_BEGIN(3) { ph3_gate(F, l); }
        PH_END(3)
        PH_BEGIN(4) { ph4_sparse(F, l); }
        PH_END(4)
        PH_BEGIN(5) { if (F.G != 256) { ph5_diag(F, l, -1, 0); GRID_BAR(); } }
        PH_END_NOBAR(5)
        PH_BEGIN(6) { if (F.G == 256) { int bx = blockIdx.x; asm volatile("" : "+s"(bx)); pg8::StaticOrder S0; S0.init(M, 6144, F.G, bx); pg8::Unit u0; (void)S0.next(0, u0);
                ph5_diag(F, l, u0.pm, u0.pn & 3); asm volatile("s_waitcnt vmcnt(0)" ::: "memory"); __syncthreads(); }
            (void)prefetch_ss_panel(F, 6144); pg8::Gemm g{XN, WT + WT_C * DM, M, 6144, DM}; pg8::StaticOrder S; S.init(M, 6144, F.G, (int)blockIdx.x);
            pg8::EpiCA E{pg8::EpiC{Qb, ACb, GA, ARG_IN(3) + (size_t)l * 2 * DM}, pg8::EpiA{GLU, SZC, GC, ARG_IN(3) + (size_t)l * 2 * DM + DM}, pg8::RowRstd{(LAS float*)(F.lds + RSTD_OFF), (LAS float*)(F.lds + RTAB_OFF), (LAS int*)(F.lds + MISC_OFF + 80), (const float*)(F.ws + WS_SS)}};
            pg8::gemm_phase<pg8::EpiCA, pg8::StaticOrder, PG8_ALIGN, PG8_SP2>(F.lds + RING_OFF, g, S, E); }
        PH_END(6)
        PH_BEGIN(7) { ph7_conv(F, l); }
        PH_END(7)
        PH_BEGIN(8) { pg8::Gemm g{ACb, WT + WT_PA * DM, M, DM, 2 * DM}; pg8::StaticOrder S; S.init(M, DM, F.G, (int)blockIdx.x);
            pg8::EpiM E{MB, GA, GC};
            pg8::gemm_phase<pg8::EpiM, pg8::StaticOrder, PG8_ALIGN, PG8_SP2>(F.lds + RING_OFF, g, S, E); }
        PH_END(8)
        PH_BEGIN(9) { pg8::Gemm g{MB, l == 0 ? WT + WT_O * DM : (bf16*)(F.ws + WS_WO1), M, DM, DM}; pg8::StaticOrder S; S.init(M, DM, F.G, (int)blockIdx.x);
            pg8::EpiOut E{(l == 0) ? ARG_IN(0) : (const float*)ARG_OUT, ARG_OUT, (l + 1 < DEPTH) ? XN : (bf16*)nullptr, ARG_IN(1) + (size_t)(l + 1 < DEPTH ? l + 1 : l) * DM, (float*)(F.ws + WS_SS)};
            pg8::gemm_phase<pg8::EpiOut, pg8::StaticOrder, PG8_ALIGN, PG8_SP2>(F.lds + RING_OFF, g, S, E); }
        PH_END_NOBAR(9)
    }
    if (PROBE_PHASE == 400 || PROBE_PHASE == 401) F.pacc += F.MISC[16];
    if (PROBE_PHASE >= 700 && PROBE_PHASE < 800) F.pacc += __hip_atomic_load(F.ctl + 96, RLX_AGENT);
    if (PROBE_PHASE >= 600) F.pacc += (clk_t ? (clk_c * 125ull) / clk_t : 0ull);
    if (PROBE_PHASE >= 0 && blockIdx.x == 0) { const unsigned long long t0_ = rt(); while (rt() - t0_ < 8ull * (probe_acc + F.pacc)) __builtin_amdgcn_s_sleep(8); }
}

extern "C" void kernel_launch(void* const* d_in, const int* in_sizes, int n_in, void* d_out, int out_size, void* d_ws, size_t ws_size, hipStream_t stream) {
    static int grid = 0;
    if (grid == 0) {
        if (n_in != 13 || in_sizes[0] != M * DM || out_size != M * DM || ws_size < WS_END) {
            fprintf(stderr, "kernel_launch: built for 13 inputs, x/out of %d floats, >= %zu bytes of workspace; got n_in %d, in0 %d, out %d, ws %zu; nothing launched\n", M * DM, (size_t)WS_END, n_in, n_in > 0 ? in_sizes[0] : -1, out_size, ws_size);
            grid = -1; return; }
        int dev = 0, cus = 0, per_cu = 0;
        if (hipGetDevice(&dev) != hipSuccess || hipDeviceGetAttribute(&cus, hipDeviceAttributeMultiprocessorCount, dev) != hipSuccess) { fprintf(stderr, "kernel_launch: device query failed\n"); grid = -1; return; }
        if (hipFuncSetAttribute((const void*)hybrid_fwd, hipFuncAttributeMaxDynamicSharedMemorySize, LDS_BYTES) != hipSuccess) { fprintf(stderr, "kernel_launch: hipFuncSetAttribute failed\n"); grid = -1; return; }
        if (hipOccupancyMaxActiveBlocksPerMultiprocessor(&per_cu, (const void*)hybrid_fwd, NWAVES * 64, LDS_BYTES) != hipSuccess || per_cu < 1)
            fprintf(stderr, "kernel_launch: note: occupancy query reports %d workgroups per CU\n", per_cu);
        (void)hipGetLastError();
        grid = cus;
    }
    if (grid < 0) return;
    if (hipMemsetAsync((char*)d_ws + WS_CTL, 0, CTL_ZERO_BYTES, stream) != hipSuccess) { fprintf(stderr, "kernel_launch: hipMemsetAsync failed\n"); return; }
    Args a{};
    for (int i = 0; i < 13; ++i) a.in[i] = (const float*)d_in[i];
    a.out = (float*)d_out; a.ws = (unsigned char*)d_ws;
#if MK_PER_PHASE
    for (int ph = 0; ph < NPHASES; ++ph) { a.ph_lo = ph; a.ph_hi = ph + 1; hipLaunchKernelGGL(hybrid_fwd, dim3(grid), dim3(NWAVES * 64), LDS_BYTES, stream, a); }
#else
    a.ph_lo = 0; a.ph_hi = NPHASES;
    hipLaunchKernelGGL(hybrid_fwd, dim3(grid), dim3(NWAVES * 64), LDS_BYTES, stream, a);
#endif
    const hipError_t le = hipPeekAtLastError();
    if (le != hipSuccess) fprintf(stderr, "kernel_launch: launch failed: %s\n", hipGetErrorName(le));
}
```

```cpp
#include <hip/hip_runtime.h>
#include <cstdio>
#include <cstdint>
namespace pg8 {
#define PG8_LAS __attribute__((address_space(3)))
typedef unsigned short bf16_t;
typedef short bf16x8 __attribute__((ext_vector_type(8)));
typedef float f32x4 __attribute__((ext_vector_type(4)));
typedef unsigned u32x4 __attribute__((ext_vector_type(4)));
constexpr int BM = 256, BK = 64, HALF = 128, HTB = HALF * BK * 2  , STAGE_BYTES = 8 * HTB, NXCD = 8, WGM = 8;

__host__ __device__ __forceinline__ int lds_byte(int r, int c) { const int st = (r >> 4) * 2 + (c >> 5), rr = r & 15, cc = c & 31, ob = rr * 64 + cc * 2; return st * 1024 + (ob ^ (((ob >> 9) & 1) << 5)); }
__host__ __device__ __forceinline__ void stage_rc(int b, int& R, int& C) { const int st = b / 1024, sb = b % 1024, swz = sb ^ (((sb >> 9) & 1) << 5); R = (st >> 1) * 16 + swz / 64; C = (st & 1) * 32 + (swz % 64) / 2; }
__host__ __device__ __forceinline__ int perm32(int rho) { const int n = rho >> 4, i = rho & 15; return 8 * (i >> 2) + 4 * n + (i & 3); }

struct Unit { int pm, pn; };
struct Gemm { const bf16_t* A; const bf16_t* Bt; int M, N, K; };

struct StaticOrder {
    int nM, nN, nwg, G, c;
    __host__ __device__ void init(int M, int N, int G_, int c_) { nM = M / BM; nN = N / BM; nwg = nM * nN; G = G_; c = c_; }
    __host__ __device__ bool next(int i, Unit& u) const {
        const long L = (long)i * G + c; if (L >= nwg) return false;
        int wgid = (int)L; { const int q = nwg / NXCD, r = nwg % NXCD, xcd = wgid % NXCD, off = wgid / NXCD; wgid = (xcd < r ? xcd * (q + 1) : r * (q + 1) + (xcd - r) * q) + off; }
        const int nig = WGM * nN, gid = wgid / nig, fm = gid * WGM, gsz = (nM - fm) < WGM ? (nM - fm) : WGM;
        u.pm = fm + ((wgid % nig) % gsz); u.pn = (wgid % nig) / gsz; return true;
    }
    __device__ __forceinline__ void a_ready(const Unit&) const {}
    __device__ __forceinline__ void done(const Unit&) const {}
};


typedef float f32x2 __attribute__((ext_vector_type(2)));
typedef __bf16 bf16x2_t __attribute__((ext_vector_type(2)));
__device__ __forceinline__ unsigned cvt_pk_bf16(float lo, float hi) { f32x2 v = {lo, hi}; bf16x2_t b = __builtin_convertvector(v, bf16x2_t); return __builtin_bit_cast(unsigned, b); }
__device__ __forceinline__ float bf_lo(unsigned w) { return __builtin_bit_cast(float, w << 16); }
__device__ __forceinline__ float bf_hi(unsigned w) { return __builtin_bit_cast(float, w & 0xffff0000u); }
__device__ __forceinline__ float sigm(float x) { return __builtin_amdgcn_rcpf(1.f + __expf(-x)); }
__device__ __forceinline__ float silu(float x) { return x * sigm(x); }
__device__ __forceinline__ u32x4 pack8(const f32x4 a, const f32x4 b) { u32x4 w; w.x = cvt_pk_bf16(a[0], a[1]); w.y = cvt_pk_bf16(a[2], a[3]); w.z = cvt_pk_bf16(b[0], b[1]); w.w = cvt_pk_bf16(b[2], b[3]); return w; }
__device__ __forceinline__ void unpack8(const u32x4 w, f32x4& a, f32x4& b) { a = (f32x4){bf_lo(w.x), bf_hi(w.x), bf_lo(w.y), bf_hi(w.y)}; b = (f32x4){bf_lo(w.z), bf_hi(w.z), bf_lo(w.w), bf_hi(w.w)}; }

struct EpiBf16 {
    static constexpr bool PERM = true, AFTER_DRAIN = false;
    bf16_t* O; int ldc; int split_cols; size_t split_stride;
    __device__ __forceinline__ void operator()(const f32x4 (&acc)[2][2][4][2], const Unit& u, int wr, int wc, int fr, int fq) const {
        const int row0 = u.pm * BM + wr * 64 + fr; int colt = u.pn * BM; bf16_t* base = O;
        if (split_cols) { const int t = colt / split_cols; base += (size_t)t * split_stride; colt -= t * split_cols; }
        const int col0 = colt + wc * 32 + 8 * fq;
#pragma unroll
        for (int ai = 0; ai < 2; ++ai)
#pragma unroll
            for (int m = 0; m < 4; ++m) { bf16_t* rowp = base + (size_t)(row0 + ai * HALF + m * 16) * ldc + col0;
#pragma unroll
                for (int bj = 0; bj < 2; ++bj) *(u32x4*)(rowp + bj * HALF) = pack8(acc[ai][bj][m][0], acc[ai][bj][m][1]); }
    }
};

struct RowRstd { PG8_LAS float* part; PG8_LAS float* tab; PG8_LAS int* words; const float* ss;
    __device__ __forceinline__ void ensure(int pm, int wid, int lane) const {
        const int have_p = __builtin_amdgcn_readfirstlane(words[0]), have_t = __builtin_amdgcn_readfirstlane(words[1]);
        if (have_t == pm) return;
        asm volatile("s_waitcnt lgkmcnt(0)" ::: "memory"); __builtin_amdgcn_s_barrier(); asm volatile("" ::: "memory");
        if (have_p != pm) {
            const char* src = (const char*)ss + (size_t)pm * 256 * 64;
#pragma unroll
            for (int i = 0; i < 2; ++i) { const int p = wid * 2 + i;
                __builtin_amdgcn_global_load_lds((const __attribute__((address_space(1))) unsigned*)(src + p * 1024 + lane * 16), (PG8_LAS unsigned*)((PG8_LAS char*)part + p * 1024), 16, 0, 0); }
            asm volatile("s_waitcnt vmcnt(0)" ::: "memory"); __builtin_amdgcn_s_barrier(); asm volatile("" ::: "memory");
        }
        const int tid = wid * 64 + lane;
        if (tid < 256) { const PG8_LAS f32x4* p = (const PG8_LAS f32x4*)(part + tid * 16); const f32x4 a = p[0], b = p[1], c = p[2], d = p[3];
            const float s = ((a[0] + a[1]) + (a[2] + a[3])) + ((b[0] + b[1]) + (b[2] + b[3])) + ((c[0] + c[1]) + (c[2] + c[3])) + ((d[0] + d[1]) + (d[2] + d[3]));
            tab[tid] = 1.0f / sqrtf(s * (1.0f / 1024.0f) + 1e-6f); }
        if (tid == 0) { words[0] = pm; words[1] = pm; }
        asm volatile("s_waitcnt lgkmcnt(0)" ::: "memory"); __builtin_amdgcn_s_barrier(); asm volatile("" ::: "memory");
    }
    __device__ __forceinline__ float get(int rl) const { return tab[rl]; } };
struct EpiQKV {
    static constexpr bool PERM = true, AFTER_DRAIN = false;
    bf16_t* Q; size_t split_stride; const float* gq; const float* gk; const unsigned short* rope; float* kmean; float qscale; PG8_LAS unsigned char* xs; int seq; RowRstd rstd;
    __device__ __forceinline__ void operator()(f32x4 (&acc)[2][2][4][2], const Unit& u, int wr, int wc, int fr_in, int fq_in) const {
        int fr = fr_in, fq = fq_in; asm volatile("" : "+v"(fr), "+v"(fq));
        u32x4 tb[2][4];
        if ((u.pn >> 2) != 2 && wc == 0) {
#pragma unroll
            for (int ai = 0; ai < 2; ++ai)
#pragma unroll
                for (int m = 0; m < 4; ++m) { const int row = u.pm * BM + ai * HALF + wr * 64 + m * 16 + fr;
                    tb[ai][m] = *(const u32x4*)((const char*)rope + (unsigned)((row & (seq - 1)) * 64 + (fq >> 1) * 32 + (fq & 1) * 16)); }
        }
        rstd.ensure(u.pm, wr * 4 + wc, fq * 16 + fr);
        { float rs[2][4];
#pragma unroll
          for (int ai = 0; ai < 2; ++ai)
#pragma unroll
            for (int m = 0; m < 4; ++m) rs[ai][m] = rstd.get(ai * HALF + wr * 64 + m * 16 + fr);
#pragma unroll
          for (int ai = 0; ai < 2; ++ai)
#pragma unroll
            for (int m = 0; m < 4; ++m)
#pragma unroll
                for (int bj = 0; bj < 2; ++bj) { acc[ai][bj][m][0] = acc[ai][bj][m][0] * rs[ai][m]; acc[ai][bj][m][1] = acc[ai][bj][m][1] * rs[ai][m]; } }
        const int sect = u.pn >> 2;
        char* base = (char*)(Q + (size_t)sect * split_stride);
        const unsigned off0 = (unsigned)(((u.pm * BM + wr * 64 + fr) * 1024 + (u.pn & 3) * BM + wc * 32 + 8 * fq) * 2);
        if (sect != 2) {
            PG8_LAS float* P = (PG8_LAS float*)xs;
#pragma unroll
            for (int ai = 0; ai < 2; ++ai)
#pragma unroll
                for (int m = 0; m < 4; ++m)
#pragma unroll
                    for (int bj = 0; bj < 2; ++bj) { const f32x4 a = acc[ai][bj][m][0], b = acc[ai][bj][m][1];
                        float s = (a[0] * a[0] + a[1] * a[1]) + (a[2] * a[2] + a[3] * a[3]) + (b[0] * b[0] + b[1] * b[1]) + (b[2] * b[2] + b[3] * b[3]);
                        s += __shfl_xor(s, 16); s += __shfl_xor(s, 32);
                        if (fq == 0) P[((ai * HALF + wr * 64 + m * 16 + fr) * 2 + bj) * 4 + wc] = s; }
            asm volatile("s_waitcnt lgkmcnt(0)" ::: "memory"); __builtin_amdgcn_s_barrier(); asm volatile("" ::: "memory");
            { const float* g = sect ? gk : gq;
              const f32x4 g0 = *(const f32x4*)(g + wc * 32 + 8 * fq), g1 = *(const f32x4*)(g + wc * 32 + 8 * fq + 4);
#pragma unroll
              for (int ai = 0; ai < 2; ++ai)
#pragma unroll
                for (int m = 0; m < 4; ++m) {
#pragma unroll
                    for (int bj = 0; bj < 2; ++bj) { const f32x4 pp = *(const PG8_LAS f32x4*)(P + ((ai * HALF + wr * 64 + m * 16 + fr) * 2 + bj) * 4);
                        const float rstd = __builtin_amdgcn_rsqf(((pp[0] + pp[1]) + (pp[2] + pp[3])) * (1.0f / 128.0f) + 1e-6f);
                        acc[ai][bj][m][0] = acc[ai][bj][m][0] * rstd * g0; acc[ai][bj][m][1] = acc[ai][bj][m][1] * rstd * g1; }
                    asm volatile("" ::: "memory"); } }
            if (wc == 0) {
                const bool lowhalf = fq < 2;
                typedef _Float16 h2_t __attribute__((ext_vector_type(2)));
#pragma unroll
                for (int ai = 0; ai < 2; ++ai)
#pragma unroll
                    for (int m = 0; m < 4; ++m) {
                        float cs[8], sn[8];
#pragma unroll
                        for (int w = 0; w < 4; ++w) { const unsigned own = tb[ai][m][w]; auto rr = __builtin_amdgcn_permlane32_swap(own, own, false, false); const unsigned oth = lowhalf ? rr[1] : rr[0];
                            const h2_t ho = __builtin_bit_cast(h2_t, own), hp = __builtin_bit_cast(h2_t, oth);
                            const float o0 = (float)ho[0], o1 = (float)ho[1], p0 = (float)hp[0], p1 = (float)hp[1];
                            cs[2 * w] = lowhalf ? o0 : p0; cs[2 * w + 1] = lowhalf ? o1 : p1; sn[2 * w] = lowhalf ? -p0 : o0; sn[2 * w + 1] = lowhalf ? -p1 : o1; }
#pragma unroll
                        for (int bj = 0; bj < 2; ++bj)
#pragma unroll
                            for (int i = 0; i < 4; ++i) {
                                { const float y = acc[ai][bj][m][0][i]; auto rr = __builtin_amdgcn_permlane32_swap(__builtin_bit_cast(unsigned, y), __builtin_bit_cast(unsigned, y), false, false);
                                  acc[ai][bj][m][0][i] = y * cs[i] + __builtin_bit_cast(float, lowhalf ? rr[1] : rr[0]) * sn[i]; }
                                { const float y = acc[ai][bj][m][1][i]; auto rr = __builtin_amdgcn_permlane32_swap(__builtin_bit_cast(unsigned, y), __builtin_bit_cast(unsigned, y), false, false);
                                  acc[ai][bj][m][1][i] = y * cs[4 + i] + __builtin_bit_cast(float, lowhalf ? rr[1] : rr[0]) * sn[4 + i]; }
                            }
                    }
            }
            if (sect == 1) {
                PG8_LAS float* KM = (PG8_LAS float*)(xs + 8192);
                float rv[16];
#pragma unroll
                for (int bj = 0; bj < 2; ++bj) { f32x4 c0 = acc[0][bj][0][0], c1 = acc[0][bj][0][1];
#pragma unroll
                    for (int ai = 0; ai < 2; ++ai)
#pragma unroll
                        for (int m = 0; m < 4; ++m) if (ai + m) { c0 += acc[ai][bj][m][0]; c1 += acc[ai][bj][m][1]; }
#pragma unroll
                    for (int i = 0; i < 4; ++i) { rv[bj * 8 + i] = c0[i]; rv[bj * 8 + 4 + i] = c1[i]; } }
#define TR_STEP(MM) { const bool up = (fr & (MM)) != 0; _Pragma("unroll") for (int i = 0; i < (MM); ++i) { const float send = up ? rv[i] : rv[i + (MM)], keep = up ? rv[i + (MM)] : rv[i]; rv[i] = keep + __shfl_xor(send, (MM)); } }
                TR_STEP(8) TR_STEP(4) TR_STEP(2) TR_STEP(1)
#undef TR_STEP
                KM[((wr * 4 + wc) * 4 + fq) * 16 + fr] = rv[0];
                asm volatile("s_waitcnt lgkmcnt(0)" ::: "memory"); __builtin_amdgcn_s_barrier(); asm volatile("" ::: "memory");
                const int tid = (wr * 4 + wc) * 64 + fq * 16 + fr;
                if (tid < 256) { const int bj = tid >> 7, d = tid & 127, w4 = d >> 5, q4 = (d >> 3) & 3, i = d & 7;
                    const float s = KM[((0 * 4 + w4) * 4 + q4) * 16 + bj * 8 + i] + KM[((1 * 4 + w4) * 4 + q4) * 16 + bj * 8 + i];
                    const int bb = u.pm >> 5, nb = u.pm & 31, head = (u.pn & 3) * 2 + bj;
                    kmean[((size_t)(bb * 8 + head) * 32 + nb) * 128 + d] = s * (1.0f / 256.0f); }
            }
        }
        const float osc = sect ? 1.f : qscale;
#pragma unroll
        for (int ai = 0; ai < 2; ++ai)
#pragma unroll
            for (int m = 0; m < 4; ++m)
#pragma unroll
                for (int bj = 0; bj < 2; ++bj) *(u32x4*)(base + off0 + (unsigned)((ai * HALF + m * 16) * 2048 + bj * 256)) = pack8(acc[ai][bj][m][0] * osc, acc[ai][bj][m][1] * osc);
    }
};
struct EpiC {
    static constexpr bool PERM = true, AFTER_DRAIN = false;
    const bf16_t* OA; bf16_t* AC; bf16_t* GA; const float* bias;
    __device__ __forceinline__ void operator()(const f32x4 (&acc)[2][2][4][2], const Unit& u, int wr, int wc, int fr, int fq) const {
        const int row0 = u.pm * BM + wr * 64 + fr;
        if (u.pn < 4) {
            const int col0 = u.pn * BM + wc * 32 + 8 * fq;
#pragma unroll
            for (int ai = 0; ai < 2; ++ai) {
                u32x4 ld[4][2];
#pragma unroll
                for (int m = 0; m < 4; ++m)
#pragma unroll
                    for (int bj = 0; bj < 2; ++bj) ld[m][bj] = __builtin_nontemporal_load((const u32x4*)(OA + (size_t)(row0 + ai * HALF + m * 16) * 1024 + col0 + bj * HALF));
#pragma unroll
                for (int m = 0; m < 4; ++m) { bf16_t* outp = AC + (size_t)(row0 + ai * HALF + m * 16) * 2048 + col0;
#pragma unroll
                    for (int bj = 0; bj < 2; ++bj) { f32x4 o0, o1; unpack8(ld[m][bj], o0, o1); const f32x4 z0 = acc[ai][bj][m][0], z1 = acc[ai][bj][m][1];
#pragma unroll
                        for (int i = 0; i < 4; ++i) { o0[i] *= silu(z0[i]); o1[i] *= silu(z1[i]); }
                        *(u32x4*)(outp + bj * HALF) = pack8(o0, o1); } }
                asm volatile("" ::: "memory"); }
        } else {
            const int col0 = (u.pn - 4) * BM + wc * 32 + 8 * fq;
            f32x4 bb[2][2];
#pragma unroll
            for (int bj = 0; bj < 2; ++bj) { bb[bj][0] = *(const f32x4*)(bias + col0 + bj * HALF); bb[bj][1] = *(const f32x4*)(bias + col0 + bj * HALF + 4); }
#pragma unroll
            for (int bj = 0; bj < 2; ++bj) { const f32x4 b0 = bb[bj][0], b1 = bb[bj][1];
#pragma unroll
                for (int ai = 0; ai < 2; ++ai)
#pragma unroll
                    for (int m = 0; m < 4; ++m) { bf16_t* rowp = GA + (size_t)(row0 + ai * HALF + m * 16) * 1024 + col0 + bj * HALF; f32x4 g0 = acc[ai][bj][m][0] + b0, g1 = acc[ai][bj][m][1] + b1;
#pragma unroll
                        for (int i = 0; i < 4; ++i) { g0[i] = sigm(g0[i]); g1[i] = sigm(g1[i]); }
                        *(u32x4*)rowp = pack8(g0, g1); } }
        }
    }
};
struct EpiA {
    static constexpr bool PERM = true, AFTER_DRAIN = false;
    bf16_t* GLU; bf16_t* SZC; bf16_t* GC; const float* bias;
    __device__ __forceinline__ void operator()(const f32x4 (&acc)[2][2][4][2], const Unit& u, int wr, int wc, int fr, int fq) const {
        const int row0 = u.pm * BM + wr * 64 + fr;
        if (u.pn < 8) {
            const int col0 = u.pn * HALF + wc * 32 + 8 * fq;
#pragma unroll
            for (int ai = 0; ai < 2; ++ai)
#pragma unroll
                for (int m = 0; m < 4; ++m) { bf16_t* rowp = GLU + (size_t)(row0 + ai * HALF + m * 16) * 1024 + col0; f32x4 a0 = acc[ai][0][m][0], a1 = acc[ai][0][m][1]; const f32x4 b0 = acc[ai][1][m][0], b1 = acc[ai][1][m][1];
#pragma unroll
                    for (int i = 0; i < 4; ++i) { a0[i] *= sigm(b0[i]); a1[i] *= sigm(b1[i]); }
                    *(u32x4*)rowp = pack8(a0, a1); }
        } else if (u.pn < 12) {
            const int col0 = (u.pn - 8) * BM + wc * 32 + 8 * fq;
#pragma unroll
            for (int ai = 0; ai < 2; ++ai)
#pragma unroll
                for (int m = 0; m < 4; ++m) { bf16_t* rowp = SZC + (size_t)(row0 + ai * HALF + m * 16) * 1024 + col0;
#pragma unroll
                    for (int bj = 0; bj < 2; ++bj) { f32x4 z0 = acc[ai][bj][m][0], z1 = acc[ai][bj][m][1];
#pragma unroll
                        for (int i = 0; i < 4; ++i) { z0[i] = silu(z0[i]); z1[i] = silu(z1[i]); }
                        *(u32x4*)(rowp + bj * HALF) = pack8(z0, z1); } }
        } else {
            const int col0 = (u.pn - 12) * BM + wc * 32 + 8 * fq;
            f32x4 bb[2][2];
#pragma unroll
            for (int bj = 0; bj < 2; ++bj) { bb[bj][0] = *(const f32x4*)(bias + col0 + bj * HALF); bb[bj][1] = *(const f32x4*)(bias + col0 + bj * HALF + 4); }
#pragma unroll
            for (int bj = 0; bj < 2; ++bj) { const f32x4 b0 = bb[bj][0], b1 = bb[bj][1];
#pragma unroll
                for (int ai = 0; ai < 2; ++ai)
#pragma unroll
                    for (int m = 0; m < 4; ++m) { bf16_t* rowp = GC + (size_t)(row0 + ai * HALF + m * 16) * 1024 + col0 + bj * HALF; f32x4 g0 = acc[ai][bj][m][0] + b0, g1 = acc[ai][bj][m][1] + b1;
#pragma unroll
                        for (int i = 0; i < 4; ++i) { g0[i] = sigm(g0[i]); g1[i] = sigm(g1[i]); }
                        *(u32x4*)rowp = pack8(g0, g1); } }
        }
    }
};
struct EpiCA {
    static constexpr bool PERM = true, AFTER_DRAIN = false;
    EpiC c; EpiA a; RowRstd rstd;
    const unsigned __attribute__((address_space(1)))* ddone; unsigned need;
    __device__ __forceinline__ void operator()(f32x4 (&acc)[2][2][4][2], const Unit& u, int wr, int wc, int fr, int fq) const {
        if (need && u.pn < 4) { while (__hip_atomic_load(ddone, __ATOMIC_RELAXED, __HIP_MEMORY_SCOPE_AGENT) < need) __builtin_amdgcn_s_sleep(1); asm volatile("" ::: "memory"); }
        rstd.ensure(u.pm, wr * 4 + wc, fq * 16 + fr);
        { int frx = fr; asm volatile("" : "+v"(frx));
          float rs[2][4];
#pragma unroll
          for (int ai = 0; ai < 2; ++ai)
#pragma unroll
            for (int m = 0; m < 4; ++m) rs[ai][m] = rstd.get(ai * HALF + wr * 64 + m * 16 + frx);
#pragma unroll
          for (int ai = 0; ai < 2; ++ai)
#pragma unroll
            for (int m = 0; m < 4; ++m)
#pragma unroll
                for (int bj = 0; bj < 2; ++bj) { acc[ai][bj][m][0] = acc[ai][bj][m][0] * rs[ai][m]; acc[ai][bj][m][1] = acc[ai][bj][m][1] * rs[ai][m]; } }
        if (u.pn < 8) c(acc, u, wr, wc, fr, fq); else { Unit v = u; v.pn = u.pn - 8; a(acc, v, wr, wc, fr, fq); }
    }
};
struct EpiM {
    static constexpr bool PERM = true, AFTER_DRAIN = false, MID = true;
    bf16_t* Mb; const bf16_t* GA; const bf16_t* GC;
    __device__ __forceinline__ void mid(f32x4 (&acc)[2][2][4][2], const Unit& u, int wr, int wc, int fr_in, int fq_in) const {
        int fr = fr_in, fq = fq_in; asm volatile("" : "+v"(fr), "+v"(fq));
        const int row0 = u.pm * BM + wr * 64 + fr, col0 = u.pn * BM + wc * 32 + 8 * fq;
#pragma unroll
        for (int ai = 0; ai < 2; ++ai)
#pragma unroll
            for (int mh = 0; mh < 2; ++mh) {
                u32x4 la[2][2], lc[2][2];
#pragma unroll
                for (int m2 = 0; m2 < 2; ++m2)
#pragma unroll
                    for (int bj = 0; bj < 2; ++bj) { const unsigned off = (unsigned)((row0 + ai * HALF + (mh * 2 + m2) * 16) * 1024 + col0 + bj * HALF); la[m2][bj] = *(const u32x4*)(GA + off); lc[m2][bj] = *(const u32x4*)(GC + off); }
#pragma unroll
                for (int m2 = 0; m2 < 2; ++m2)
#pragma unroll
                    for (int bj = 0; bj < 2; ++bj) { const int m = mh * 2 + m2; f32x4 a0, a1, c0, c1; unpack8(la[m2][bj], a0, a1); unpack8(lc[m2][bj], c0, c1);
#pragma unroll
                        for (int i = 0; i < 4; ++i) { acc[ai][bj][m][0][i] *= a0[i] * __builtin_amdgcn_rcpf(c0[i]); acc[ai][bj][m][1][i] *= a1[i] * __builtin_amdgcn_rcpf(c1[i]); } }
                asm volatile("" ::: "memory"); }
    }
    __device__ __forceinline__ void operator()(const f32x4 (&acc)[2][2][4][2], const Unit& u, int wr, int wc, int fr_in, int fq_in) const {
        int fr = fr_in, fq = fq_in; asm volatile("" : "+v"(fr), "+v"(fq));
        const int row0 = u.pm * BM + wr * 64 + fr, col0 = u.pn * BM + wc * 32 + 8 * fq;
#pragma unroll
        for (int ai = 0; ai < 2; ++ai) {
            u32x4 lc[4][2];
#pragma unroll
            for (int m = 0; m < 4; ++m)
#pragma unroll
                for (int bj = 0; bj < 2; ++bj) lc[m][bj] = *(const u32x4*)(GC + (unsigned)((row0 + ai * HALF + m * 16) * 1024 + col0 + bj * HALF));
#pragma unroll
            for (int m = 0; m < 4; ++m)
#pragma unroll
                for (int bj = 0; bj < 2; ++bj) { f32x4 c0, c1; unpack8(lc[m][bj], c0, c1);
                    *(u32x4*)(Mb + (unsigned)((row0 + ai * HALF + m * 16) * 1024 + col0 + bj * HALF)) = pack8(c0 * acc[ai][bj][m][0], c1 * acc[ai][bj][m][1]); }
            asm volatile("" ::: "memory"); }
    }
};
struct EpiOut {
    static constexpr bool PERM = false, AFTER_DRAIN = false;
    const float* xres; float* out; bf16_t* xn; const float* gnext; float* ss;
    __device__ __forceinline__ void operator()(const f32x4 (&acc)[2][2][4][2], const Unit& u, int wr, int wc, int fr_in, int fq_in) const {
        int fr = fr_in, fq = fq_in; asm volatile("" : "+v"(fr), "+v"(fq));
        const int row0 = u.pm * BM + wr * 64 + fr, col0 = u.pn * BM + wc * 32 + 4 * fq;
        f32x4 gv[2][2];
        if (xn) {
#pragma unroll
            for (int bj = 0; bj < 2; ++bj)
#pragma unroll
                for (int n = 0; n < 2; ++n) gv[bj][n] = *(const f32x4*)(gnext + col0 + bj * HALF + n * 16); }
#pragma unroll
        for (int ai = 0; ai < 2; ++ai) {
            f32x4 xr[4][2][2];
#pragma unroll
            for (int m = 0; m < 4; ++m)
#pragma unroll
                for (int bj = 0; bj < 2; ++bj)
#pragma unroll
                    for (int n = 0; n < 2; ++n) xr[m][bj][n] = *(const f32x4*)(xres + (unsigned)((row0 + ai * HALF + m * 16) * 1024 + col0) + bj * HALF + n * 16);
#pragma unroll
            for (int m = 0; m < 4; ++m) { const unsigned off = (unsigned)((row0 + ai * HALF + m * 16) * 1024 + col0); float s = 0.f;
#pragma unroll
                for (int bj = 0; bj < 2; ++bj)
#pragma unroll
                    for (int n = 0; n < 2; ++n) { const f32x4 o = xr[m][bj][n] + acc[ai][bj][m][n]; *(f32x4*)(out + off + bj * HALF + n * 16) = o;
                        if (xn) { s += (o[0] * o[0] + o[1] * o[1]) + (o[2] * o[2] + o[3] * o[3]); const f32x4 y = o * gv[bj][n];
                            *(unsigned long long*)(xn + off + bj * HALF + n * 16) = (unsigned long long)cvt_pk_bf16(y[0], y[1]) | ((unsigned long long)cvt_pk_bf16(y[2], y[3]) << 32); } }
                if (xn) { s += __shfl_xor(s, 16); s += __shfl_xor(s, 32); if (fq == 0) ss[(unsigned)((row0 + ai * HALF + m * 16) * 16 + u.pn * 4 + wc)] = s; } }
            asm volatile("" ::: "memory"); }
    }
};

template <class T, class = void> struct epi_has_mid { static constexpr bool value = false; };
template <class T> struct epi_has_mid<T, decltype((void)T::MID)> { static constexpr bool value = T::MID; };
template <class Epi, class Sched, bool ALIGN_EPI = false, bool SP2 = false>
__device__ __forceinline__ void gemm_phase(PG8_LAS unsigned char* lds, const Gemm g, const Sched& S, const Epi& E) {
    int tid_ = threadIdx.x; asm volatile("" : "+v"(tid_));
    const int tid = tid_, wid = __builtin_amdgcn_readfirstlane(tid >> 6), lane = tid & 63, wr = wid >> 2, wc = wid & 3, fr = lane & 15, fq = lane >> 4;
    const int K = g.K, nt = K / BK;
    unsigned voffA[2], voffB[2];
#pragma unroll
    for (int i = 0; i < 2; ++i) { int R, C; stage_rc(tid * 16 + i * 8192, R, C); const int Rb = Epi::PERM ? ((R & ~31) + perm32(R & 31)) : R;
        voffA[i] = (unsigned)(R * K + C) * 2u; voffB[i] = (unsigned)(Rb * K + C) * 2u; }
    const size_t kstep = (size_t)(BK * 2);
    const size_t hstep = (size_t)HALF * K * 2;
    const size_t tstep = 2 * hstep;
    const unsigned ldsw = (unsigned)wid * 1024u;
    const int aoff = lds_byte(wr * 64 + fr, fq * 8), boff = lds_byte(wc * 32 + fr, fq * 8);
#define PG8_SA(b, h) (((b) * 2 + (h)) * HTB)
#define PG8_SB(b, h) ((4 + (b) * 2 + (h)) * HTB)
#define PG8_STAGE(bufoff, gbase, voff) do { _Pragma("unroll") for (int _i = 0; _i < 2; ++_i) \
        __builtin_amdgcn_global_load_lds((const unsigned*)((const char*)(gbase) + (voff)[_i]), (PG8_LAS unsigned*)(lds + (bufoff) + ldsw + _i * 8192), 16, 0, 0); } while (0)
#define PG8_LDA(dst, b, h) do { _Pragma("unroll") for (int m = 0; m < 4; ++m) _Pragma("unroll") for (int k = 0; k < 2; ++k) dst[m][k] = *(const PG8_LAS bf16x8*)(lds + PG8_SA(b, h) + aoff + m * 2048 + k * 1024); } while (0)
#define PG8_LDB(dst, b, h) do { _Pragma("unroll") for (int n = 0; n < 2; ++n) _Pragma("unroll") for (int k = 0; k < 2; ++k) dst[n][k] = *(const PG8_LAS bf16x8*)(lds + PG8_SB(b, h) + boff + n * 2048 + k * 1024); } while (0)
#define PG8_MMA(ai, bj, At, Bt) do { __builtin_amdgcn_s_setprio(1); _Pragma("unroll") for (int m = 0; m < 4; ++m) _Pragma("unroll") for (int n = 0; n < 2; ++n) _Pragma("unroll") for (int k = 0; k < 2; ++k) \
        acc[ai][bj][m][n] = __builtin_amdgcn_mfma_f32_16x16x32_bf16(Bt[n][k], At[m][k], acc[ai][bj][m][n], 0, 0, 0); __builtin_amdgcn_s_setprio(0); } while (0)
#define PG8_WAIT_V(n) asm volatile("s_waitcnt vmcnt(" #n ")" ::: "memory")
#define PG8_WAIT_L(n) asm volatile("s_waitcnt lgkmcnt(" #n ")" ::: "memory")
#define PG8_BAR __builtin_amdgcn_s_barrier()
#define PG8_SCHED __builtin_amdgcn_sched_barrier(0)
    Unit cur, nxt; int ui = 0;
    if (!S.next(0, cur)) return;
    f32x4 acc[2][2][4][2];
#pragma unroll
    for (int a = 0; a < 2; ++a)
#pragma unroll
        for (int b = 0; b < 2; ++b)
#pragma unroll
            for (int m = 0; m < 4; ++m)
#pragma unroll
                for (int n = 0; n < 2; ++n) acc[a][b][m][n] = (f32x4){0.f, 0.f, 0.f, 0.f};
    bf16x8 At[4][2], B0[2][2], B1[2][2];
    const char* cA = (const char*)g.A + (size_t)cur.pm * tstep; const char* cB = (const char*)g.Bt + (size_t)cur.pn * tstep;
    S.a_ready(cur);
    if constexpr (SP2) {
        PG8_STAGE(PG8_SB(0, 0), cB, voffB); PG8_STAGE(PG8_SB(0, 1), cB + hstep, voffB); PG8_STAGE(PG8_SA(0, 0), cA, voffA); PG8_STAGE(PG8_SA(0, 1), cA + hstep, voffA);
        if (wr == 1) PG8_BAR;
        PG8_WAIT_V(2); PG8_BAR;
        PG8_STAGE(PG8_SB(1, 0), cB + kstep, voffB); PG8_STAGE(PG8_SA(1, 0), cA + kstep, voffA); PG8_STAGE(PG8_SB(1, 1), cB + hstep + kstep, voffB);
        PG8_WAIT_V(6); PG8_BAR;
    } else {
        PG8_STAGE(PG8_SB(0, 0), cB, voffB); PG8_STAGE(PG8_SA(0, 0), cA, voffA); PG8_STAGE(PG8_SB(0, 1), cB + hstep, voffB); PG8_STAGE(PG8_SA(0, 1), cA + hstep, voffA);
        if (wr == 1) PG8_BAR;
        PG8_WAIT_V(4); PG8_BAR;
        PG8_STAGE(PG8_SB(1, 0), cB + kstep, voffB); PG8_STAGE(PG8_SA(1, 0), cA + kstep, voffA); PG8_STAGE(PG8_SB(1, 1), cB + hstep + kstep, voffB);
        PG8_WAIT_V(6); PG8_BAR;
    }
    for (;;) {
        const bool has_next = S.next(ui + 1, nxt);
        const char* nA = has_next ? (const char*)g.A + (size_t)nxt.pm * tstep : cA; const char* nB = has_next ? (const char*)g.Bt + (size_t)nxt.pn * tstep : cB;
        for (int t = 0; t < nt; t += 2) {
            if constexpr (epi_has_mid<Epi>::value) { if (t == nt / 2) E.mid(acc, cur, wr, wc, fr, fq); }
            const bool last = (t == nt - 2);
            const char* a1 = cA + (size_t)(t + 1) * kstep;
            const char* a2 = last ? nA : cA + (size_t)(t + 2) * kstep; const char* b2 = last ? nB : cB + (size_t)(t + 2) * kstep;
            const char* a3 = a2 + kstep; const char* b3 = b2 + kstep;
            if (last && has_next) S.a_ready(nxt);
            if constexpr (SP2) {
            PG8_LDB(B0, 0, 0); PG8_LDB(B1, 0, 1); PG8_SCHED; PG8_LDA(At, 0, 0); PG8_STAGE(PG8_SA(1, 1), a1 + hstep, voffA);
            PG8_WAIT_V(8); PG8_WAIT_L(0); PG8_BAR; PG8_MMA(0, 0, At, B0); PG8_MMA(0, 1, At, B1); PG8_BAR; PG8_SCHED;
            PG8_LDA(At, 0, 1); PG8_STAGE(PG8_SB(0, 0), b2, voffB); PG8_STAGE(PG8_SB(0, 1), b2 + hstep, voffB); PG8_STAGE(PG8_SA(0, 0), a2, voffA);
            PG8_WAIT_V(8); PG8_WAIT_L(0); PG8_BAR; PG8_MMA(1, 0, At, B0); PG8_MMA(1, 1, At, B1); PG8_BAR; PG8_SCHED;
            PG8_LDB(B0, 1, 0); PG8_LDB(B1, 1, 1); PG8_SCHED; PG8_LDA(At, 1, 0); PG8_STAGE(PG8_SA(0, 1), a2 + hstep, voffA);
            PG8_WAIT_V(8); PG8_WAIT_L(0); PG8_BAR; PG8_MMA(0, 0, At, B0); PG8_MMA(0, 1, At, B1); PG8_BAR; PG8_SCHED;
            PG8_LDA(At, 1, 1); PG8_STAGE(PG8_SB(1, 0), b3, voffB); PG8_STAGE(PG8_SB(1, 1), b3 + hstep, voffB); PG8_STAGE(PG8_SA(1, 0), a3, voffA);
            PG8_WAIT_V(8); PG8_WAIT_L(0); PG8_BAR; PG8_MMA(1, 0, At, B0); PG8_MMA(1, 1, At, B1); PG8_BAR; PG8_SCHED;
            } else {
            PG8_LDB(B0, 0, 0); PG8_SCHED; PG8_LDA(At, 0, 0); PG8_STAGE(PG8_SA(1, 1), a1 + hstep, voffA);
            PG8_WAIT_L(8); PG8_BAR; PG8_WAIT_L(0); PG8_MMA(0, 0, At, B0); PG8_BAR; PG8_SCHED;
            PG8_LDB(B1, 0, 1); PG8_STAGE(PG8_SB(0, 0), b2, voffB);
            PG8_BAR; PG8_WAIT_L(0); PG8_MMA(0, 1, At, B1); PG8_BAR;
            PG8_LDA(At, 0, 1); PG8_STAGE(PG8_SA(0, 0), a2, voffA);
            PG8_BAR; PG8_WAIT_L(0); PG8_MMA(1, 0, At, B0); PG8_BAR; PG8_SCHED;
            PG8_STAGE(PG8_SB(0, 1), b2 + hstep, voffB);
            PG8_WAIT_V(6); PG8_BAR; PG8_MMA(1, 1, At, B1); PG8_BAR;
            PG8_LDB(B0, 1, 0); PG8_SCHED; PG8_LDA(At, 1, 0); PG8_STAGE(PG8_SA(0, 1), a2 + hstep, voffA);
            PG8_WAIT_L(8); PG8_BAR; PG8_WAIT_L(0); PG8_MMA(0, 0, At, B0); PG8_BAR; PG8_SCHED;
            PG8_LDB(B1, 1, 1); PG8_STAGE(PG8_SB(1, 0), b3, voffB);
            PG8_BAR; PG8_WAIT_L(0); PG8_MMA(0, 1, At, B1); PG8_BAR;
            PG8_LDA(At, 1, 1); PG8_STAGE(PG8_SA(1, 0), a3, voffA);
            PG8_BAR; PG8_WAIT_L(0); PG8_MMA(1, 0, At, B0); PG8_BAR; PG8_SCHED;
            PG8_STAGE(PG8_SB(1, 1), b3 + hstep, voffB);
            PG8_WAIT_V(6); PG8_BAR; PG8_MMA(1, 1, At, B1); PG8_BAR;
            }
        }
        if constexpr (ALIGN_EPI) { if (wr == 0) PG8_BAR; }
#if defined(PROBE_PHASE) && (PROBE_PHASE == 400 || PROBE_PHASE == 401)
        { __builtin_amdgcn_sched_barrier(0); const unsigned long long t0_ = __builtin_amdgcn_s_memrealtime(); __builtin_amdgcn_sched_barrier(0);
          if constexpr (!Epi::AFTER_DRAIN) { E(acc, cur, wr, wc, fr, fq); S.done(cur); }
          if (PROBE_PHASE == 400) asm volatile("s_waitcnt vmcnt(0)" ::: "memory"); __builtin_amdgcn_sched_barrier(0); const unsigned long long t1_ = __builtin_amdgcn_s_memrealtime();
          if (lane == 0 && wid == 0) *(volatile PG8_LAS unsigned*)(lds + 131072 + 320 + 64) += (unsigned)(t1_ - t0_); }
#else
        if constexpr (!Epi::AFTER_DRAIN) { E(acc, cur, wr, wc, fr, fq); S.done(cur); }
#endif
        if (!has_next) break;
#pragma unroll
        for (int a = 0; a < 2; ++a)
#pragma unroll
            for (int b = 0; b < 2; ++b)
#pragma unroll
                for (int m = 0; m < 4; ++m)
#pragma unroll
                    for (int n = 0; n < 2; ++n) acc[a][b][m][n] = (f32x4){0.f, 0.f, 0.f, 0.f};
        cur = nxt; cA = nA; cB = nB; ++ui;
        if constexpr (ALIGN_EPI) { if (wr == 1) PG8_BAR; }
    }
    PG8_WAIT_V(0);
    if constexpr (!ALIGN_EPI) { if (wr == 0) PG8_BAR; }
    PG8_BAR;
    if constexpr (Epi::AFTER_DRAIN) { E.fused(acc, cur, wr, wc, fr, fq, lds, wid, lane); S.done(cur); }
#undef PG8_SA
#undef PG8_SB
#undef PG8_STAGE
#undef PG8_LDA
#undef PG8_LDB
#undef PG8_MMA
#undef PG8_WAIT_V
#undef PG8_WAIT_L
#undef PG8_BAR
#undef PG8_SCHED
}
}

#ifndef PG8_SP2
#define PG8_SP2 true
#endif
#ifndef PG8_ALIGN
#define PG8_ALIGN true
#endif
#ifndef MK_PER_PHASE
#define MK_PER_PHASE 0
#endif

constexpr int NWAVES = 8;
constexpr int BATCH = 2, SEQ = 8192, DM = 1024, DEPTH = 2, NH = 8, HD = 128, NBLK = 32, MOBA = 256, CK = 31;
constexpr int M = BATCH * SEQ;
constexpr int N_IN = 9216;
constexpr float EPS = 1e-6f;
constexpr float QSCALE = 0.08838834764831845f * 1.4426950408889634f;
constexpr int NPHASE_L = 10, NPHASES = NPHASE_L * DEPTH;

constexpr size_t MiB = 1u << 20;
constexpr size_t WS_CTL = 0, CTL_ZERO_BYTES = 65536;
constexpr size_t WS_ROPE = 1 * MiB;
constexpr size_t WS_KMEAN = 2 * MiB;
constexpr size_t WS_LPART = 2 * MiB + 512 * 1024;
constexpr size_t WS_WT = 4 * MiB;
constexpr size_t WT_B = 0, WT_C = 3072, WT_A = 5120, WT_PA = 9216, WT_PC = 10240, WT_O = 11264, WT_ROWS = 12288;
constexpr size_t WS_XN = 28 * MiB;
constexpr size_t WS_Q = 60 * MiB, WS_K = 92 * MiB, WS_V = 124 * MiB;
constexpr size_t WS_LIST = 156 * MiB;
constexpr size_t WS_PART = 172 * MiB;
constexpr size_t WS_GA = 92 * MiB, WS_GLU = 124 * MiB, WS_SZC = 156 * MiB, WS_GC = 188 * MiB, WS_AC = 220 * MiB  , WS_SS = 284 * MiB  , WS_WO1 = 285 * MiB  , WS_END = 287 * MiB;
constexpr size_t WS_MB = WS_Q;
constexpr int CW_BAR = 1024;
constexpr int CW_CNT = 8192;
constexpr int CW_DDONE = 9472;
static_assert((CW_DDONE + DEPTH * 64) * 4 <= (int)CTL_ZERO_BYTES && CW_CNT + DEPTH * 512 <= CW_DDONE && CW_BAR + 3456 <= CW_CNT, "CTL map");

constexpr int RING_OFF = 0, RING_BYTES = 131072;
constexpr int LDSCTL_OFF = RING_BYTES, MISC_OFF = LDSCTL_OFF + 320;
constexpr int XTRA_OFF = RING_BYTES + 512;
constexpr int STG_OFF = XTRA_OFF + 8192;
constexpr int LDS_BYTES = 163840;
constexpr int RSTD_OFF = STG_OFF + 2048;
constexpr int RTAB_OFF = RSTD_OFF + 16384;
static_assert(RTAB_OFF + 1024 <= LDS_BYTES, "LDS map");
static_assert(STG_OFF + 8 * 2176 <= LDS_BYTES, "LDS map");
#define GAS __attribute__((address_space(1)))
#define LAS __attribute__((address_space(3)))
typedef unsigned short bf16;
typedef unsigned v4u __attribute__((ext_vector_type(4)));
typedef float f32x4 __attribute__((ext_vector_type(4)));
typedef short bf16x8 __attribute__((ext_vector_type(8)));
typedef GAS unsigned gu32;
typedef GAS unsigned long long gu64;
#define RLX_AGENT __ATOMIC_RELAXED, __HIP_MEMORY_SCOPE_AGENT
#define LDS_WAIT() asm volatile("s_waitcnt lgkmcnt(0)" ::: "memory")
#define VM_WAIT() asm volatile("s_waitcnt vmcnt(0)" ::: "memory")
__device__ __forceinline__ unsigned long long rt() { return __builtin_amdgcn_s_memrealtime(); }
__device__ __forceinline__ unsigned f2bf(float f) { unsigned u = __builtin_bit_cast(unsigned, f); return (u + 0x7fffu + ((u >> 16) & 1u)) >> 16; }
__device__ __forceinline__ unsigned pk2(float lo, float hi) { return f2bf(lo) | (f2bf(hi) << 16); }

#define XB_TMO      128
#define XB_XCNT(j)  (256  + 64 * (j))
#define XB_XSUB(j)  (1280 + 64 * (j))
#define XB_XGEN(j)  (2304 + 64 * (j))
#define XB_TOP      3328
#define XB_TOPGEN   3392
#define XCD_BAR_WORDS 3456
#define XB_SPIN_CAP (1u << 18)

__device__ __forceinline__ unsigned xb_ld(unsigned* p)              { return __hip_atomic_load(p, __ATOMIC_RELAXED, __HIP_MEMORY_SCOPE_AGENT); }
__device__ __forceinline__ unsigned xb_add(unsigned* p, unsigned v) { return __hip_atomic_fetch_add(p, v, __ATOMIC_RELAXED, __HIP_MEMORY_SCOPE_AGENT); }
__device__ __forceinline__ unsigned xb_xcc_id() { return (unsigned)__builtin_amdgcn_s_getreg((3 << 11) | 20) & 0xFu; }
#define XB_SPIN(cond, bar) do { unsigned _sp = 0; while (cond) { __builtin_amdgcn_s_sleep(1); \
    if ((++_sp & 255u) == 0u) { if (xb_ld(&(bar)[XB_TMO])) break; if (_sp > XB_SPIN_CAP) { atomicAdd(&(bar)[XB_TMO], 1u); break; } } } } while (0)

struct XcdBarrier {
    unsigned* bar; unsigned x;
    volatile LAS unsigned* st;
};

__device__ __forceinline__ XcdBarrier xcd_barrier_post(unsigned* bar, volatile LAS unsigned* st) {
    XcdBarrier b; b.bar = bar; b.x = xb_xcc_id(); b.st = st;
    if (threadIdx.x == 0) (void)xb_add(&bar[XB_XCNT(b.x)], 1u);
    return b;
}
__device__ __forceinline__ void xcd_barrier_complete(unsigned* bar, unsigned x, unsigned& nloc, unsigned& nx) {
    const unsigned G = gridDim.x * gridDim.y * gridDim.z;
    unsigned sum, cnt, mine, sp = 0u;
    for (;;) {
        sum = 0u; cnt = 0u; mine = 0u;
#pragma unroll
        for (unsigned j = 0; j < 16; ++j) { const unsigned c = xb_ld(&bar[XB_XCNT(j)]); sum += c; cnt += (c > 0u) ? 1u : 0u; mine = (j == x) ? c : mine; }
        if (sum == G) break;
        __builtin_amdgcn_s_sleep(1);
        if ((++sp & 255u) == 0u) { if (xb_ld(&bar[XB_TMO])) break; if (sp > XB_SPIN_CAP) { atomicAdd(&bar[XB_TMO], 1u); break; } }
    }
    nloc = mine > 0u ? mine : 1u; nx = cnt > 0u ? cnt : 1u;
}

__device__ __forceinline__ void xcd_barrier(const XcdBarrier& b) {
    asm volatile("s_waitcnt vmcnt(0)" ::: "memory");
    __syncthreads();
    if (threadIdx.x == 0) {
        GAS unsigned* bar_g = (GAS unsigned*)b.bar; unsigned bx_ = b.x;
        asm volatile("" : "+s"(bar_g), "+s"(bx_)); unsigned* bar = (unsigned*)bar_g;
        __builtin_amdgcn_s_waitcnt(0);
        unsigned nloc = b.st[0], nx = b.st[1];
        if (nloc == 0u) { xcd_barrier_complete(bar, bx_, nloc, nx); b.st[0] = nloc; b.st[1] = nx; }
        const unsigned old = xb_add(&bar[XB_XSUB(bx_)], 1u);
        const unsigned gen = old / nloc;
        if (old + 1u == (gen + 1u) * nloc) {
            __builtin_amdgcn_fence(__ATOMIC_RELEASE, "agent");
            asm volatile("s_waitcnt vmcnt(0)" ::: "memory");
            const unsigned og = xb_add(&bar[XB_TOP], 1u);
            const unsigned tg = og / nx;
            if (og + 1u == (tg + 1u) * nx) xb_add(&bar[XB_TOPGEN], 1u);
            else XB_SPIN(xb_ld(&bar[XB_TOPGEN]) == tg, bar);
            __builtin_amdgcn_fence(__ATOMIC_ACQUIRE, "agent");
            xb_add(&bar[XB_XGEN(bx_)], 1u);
            asm volatile("s_waitcnt vmcnt(0)" ::: "memory");
        } else {
            XB_SPIN(xb_ld(&bar[XB_XGEN(bx_)]) == gen, bar);
            __builtin_amdgcn_fence(__ATOMIC_ACQUIRE, "agent");
            asm volatile("s_waitcnt vmcnt(0)" ::: "memory");
        }
    }
    __syncthreads();
}

typedef float f32x16 __attribute__((ext_vector_type(16)));
typedef short v4i16_t __attribute__((ext_vector_type(4)));
typedef float f32x2v __attribute__((ext_vector_type(2)));
struct Frame {
    LAS unsigned char* lds;
    volatile LAS unsigned* MISC;
    gu32* ctl;
    int tid, lane, wave;
    int vcu, G;
    unsigned char* ws;
    unsigned long long pacc, pt0;
};
#ifndef PROBE_PHASE
#define PROBE_PHASE -1
#endif
#define PSUB_BEGIN(code) do { if (PROBE_PHASE == (code)) { __builtin_amdgcn_sched_barrier(0); F.pt0 = rt(); __builtin_amdgcn_sched_barrier(0); } } while (0)
#define PSUB_END(code) do { if (PROBE_PHASE == (code)) { __builtin_amdgcn_sched_barrier(0); F.pacc += rt() - F.pt0; __builtin_amdgcn_sched_barrier(0); } } while (0)
struct Args { const float* in[13]; float* out; unsigned char* ws; int ph_lo, ph_hi; };
#define KARG ((const volatile __attribute__((address_space(4))) Args*)__builtin_amdgcn_kernarg_segment_ptr())
#define ARG_IN(i) ((const float*)KARG->in[i])
#define ARG_OUT ((float*)KARG->out)
__device__ __forceinline__ float wave_sum(float v) {
#pragma unroll
    for (int o = 1; o < 64; o <<= 1) v += __shfl_xor(v, o);
    return v;
}
__device__ __forceinline__ float wave_max(float v) {
#pragma unroll
    for (int o = 1; o < 64; o <<= 1) v = fmaxf(v, __shfl_xor(v, o));
    return v;
}
using pg8::cvt_pk_bf16; using pg8::bf_lo; using pg8::bf_hi; using pg8::sigm; using pg8::silu;

__device__ __forceinline__ void p0_transpose_item(const float* W, int ldw, int src_col0, bf16* WT, int dst_row0, int dpitch, int dk0, int k0, LAS float* scr, int lane) {
    f32x4 wv[8];
    const float* src = W + (size_t)(k0 + (lane >> 3)) * ldw + src_col0 + 4 * (lane & 7);
#pragma unroll
    for (int i = 0; i < 8; ++i) wv[i] = __builtin_nontemporal_load((const GAS f32x4*)(src + (size_t)(8 * i) * ldw));
#pragma unroll
    for (int i = 0; i < 8; ++i) { const int kk = 8 * i + (lane >> 3), n0 = 4 * (lane & 7); *(LAS f32x4*)(scr + kk * 36 + (n0 ^ (8 * ((kk >> 4) & 3)))) = wv[i]; }
    LDS_WAIT(); asm volatile("" ::: "memory");
    const int c = lane & 7;
#pragma unroll
    for (int j = 0; j < 4; ++j) { const int n = (lane >> 3) + 8 * j; float t[8];
#pragma unroll
        for (int q = 0; q < 8; ++q) { const int kk = 8 * c + q; t[q] = scr[kk * 36 + (n ^ (8 * ((c >> 1) & 3)))]; }
        v4u o; o.x = pk2(t[0], t[1]); o.y = pk2(t[2], t[3]); o.z = pk2(t[4], t[5]); o.w = pk2(t[6], t[7]);
        *(GAS v4u*)(WT + (size_t)(dst_row0 + n) * dpitch + dk0 + k0 + 8 * c) = o; }
    LDS_WAIT(); asm volatile("" ::: "memory");
}
__device__ __forceinline__ void ph0_prologue(Frame& F, int l, const float* xin) {
    LAS float* scr = (LAS float*)(F.lds + RING_OFF + F.wave * 16384);
    const int gw = F.vcu * NWAVES + F.wave, NGW = F.G * NWAVES;
    bf16* WT = (bf16*)(F.ws + WS_WT);
    const float* w_in = ARG_IN(2) + (size_t)l * DM * N_IN;
    const float* w_pa = ARG_IN(10) + (size_t)l * DM * DM; const float* w_pc = ARG_IN(11) + (size_t)l * DM * DM; const float* w_o = ARG_IN(12) + (size_t)l * DM * DM;
    PSUB_BEGIN(300);
    constexpr int NRB = WT_ROWS / 32, NITEMS = NRB * (DM / 64);
    for (int it = gw; it < NITEMS; it += NGW) {
        const int rb = it % NRB, kb = it / NRB, r = rb * 32;
        const float* W; int ldw, src, drow = r, dpitch = DM, dk0 = 0;
        if (r < (int)WT_C) { W = w_in; ldw = N_IN; src = r; }
        else if (r < (int)WT_A) { const int q = r - (int)WT_C; W = w_in; ldw = N_IN; src = q < 1024 ? 3072 + q : 7168 + (q - 1024); }
        else if (r < (int)WT_PA) { const int q = r - (int)WT_A; W = w_in; ldw = N_IN;
            if (q < 2048) { const int pn = q >> 8, bj = (q >> 7) & 1, i = q & 127; src = 4096 + 1024 * bj + 128 * pn + i; }
            else if (q < 3072) src = 6144 + (q - 2048);
            else src = 8192 + (q - 3072); }
        else if (r < (int)WT_O) {
            const int q = r - (int)WT_PA, half = q >> 10; W = half ? w_pc : w_pa; ldw = DM; src = q & 1023;
            WT = (bf16*)(F.ws + WS_WT) + WT_PA * DM; drow = q & 1023; dpitch = 2 * DM; dk0 = half * DM; }
        else { W = w_o; ldw = DM; src = r - (int)WT_O; if (l == 1) { WT = (bf16*)(F.ws + WS_WO1); drow = r - (int)WT_O; } }
        p0_transpose_item(W, ldw, src, WT, drow, dpitch, dk0, kb * 64, scr, F.lane);
        WT = (bf16*)(F.ws + WS_WT);
    }
    PSUB_END(300); PSUB_BEGIN(301);
    if (l == 0) {
        const float* g = ARG_IN(1); bf16* XN = (bf16*)(F.ws + WS_XN); float* SS = (float*)(F.ws + WS_SS);
        f32x4 gv[4];
#pragma unroll
        for (int j = 0; j < 4; ++j) gv[j] = ((const GAS f32x4*)g)[F.lane + 64 * j];
        for (int m = gw; m < M; m += 2 * NGW) {
            const int m2 = m + NGW;
            const GAS f32x4* xr = (const GAS f32x4*)(xin + (size_t)m * DM) + F.lane; const GAS f32x4* xr2 = (const GAS f32x4*)(xin + (size_t)m2 * DM) + F.lane;
            f32x4 v[4], v2[4]; float s = 0.f, s2 = 0.f;
#pragma unroll
            for (int j = 0; j < 4; ++j) { v[j] = xr[64 * j]; v2[j] = xr2[64 * j]; }
#pragma unroll
            for (int j = 0; j < 4; ++j) { s += (v[j].x * v[j].x + v[j].y * v[j].y) + (v[j].z * v[j].z + v[j].w * v[j].w); s2 += (v2[j].x * v2[j].x + v2[j].y * v2[j].y) + (v2[j].z * v2[j].z + v2[j].w * v2[j].w); }
            s = wave_sum(s); s2 = wave_sum(s2);
            if (F.lane < 16) { SS[(size_t)m * 16 + F.lane] = F.lane == 0 ? s : 0.f; SS[(size_t)m2 * 16 + F.lane] = F.lane == 0 ? s2 : 0.f; }
            GAS unsigned long long* o8 = (GAS unsigned long long*)(XN + (size_t)m * DM) + F.lane; GAS unsigned long long* o82 = (GAS unsigned long long*)(XN + (size_t)m2 * DM) + F.lane;
#pragma unroll
            for (int j = 0; j < 4; ++j) { const f32x4 y = v[j] * gv[j]; o8[64 * j] = (unsigned long long)cvt_pk_bf16(y.x, y.y) | ((unsigned long long)cvt_pk_bf16(y.z, y.w) << 32);
                const f32x4 y2 = v2[j] * gv[j]; o82[64 * j] = (unsigned long long)cvt_pk_bf16(y2.x, y2.y) | ((unsigned long long)cvt_pk_bf16(y2.z, y2.w) << 32); }
        }
    }
    PSUB_END(301);
    if (blockIdx.x == 0) { gu32* cnt = F.ctl + CW_CNT + l * 512; cnt[F.tid] = 0u; }
    if (l == 0) {
        _Float16* rt16 = (_Float16*)(F.ws + WS_ROPE);
        constexpr float IF[16] = {1.000000000e+00f, 4.403665960e-01f, 1.939227432e-01f, 8.539710194e-02f, 3.760603070e-02f, 1.656044088e-02f, 7.292664610e-03f, 3.211446106e-03f,
                                  1.414213562e-03f, 6.227724371e-04f, 2.742481884e-04f, 1.207697351e-04f, 5.318295734e-05f, 2.341999971e-05f, 1.031338525e-05f, 4.541670478e-06f};
        for (int t = (F.vcu * NWAVES + F.wave) * 64 + F.lane; t < SEQ; t += NGW * 64) {
#pragma unroll
            for (int i = 0; i < 16; ++i) { float sn, cs; sincosf((float)t * IF[i], &sn, &cs); rt16[t * 32 + i] = (_Float16)cs; rt16[t * 32 + 16 + i] = (_Float16)sn; }
        }
    }
}

__device__ __forceinline__ int prefetch_ss_panel(Frame& F, int N) {
    int bx = blockIdx.x; asm volatile("" : "+s"(bx));
    pg8::StaticOrder S; S.init(M, N, F.G, bx); pg8::Unit u; if (!S.next(0, u)) return -1;
    const char* src = (const char*)(F.ws + WS_SS) + (size_t)u.pm * 256 * 64;
#pragma unroll
    for (int i = 0; i < 2; ++i) { const int p = F.wave * 2 + i;
        __builtin_amdgcn_global_load_lds((const GAS unsigned*)(src + p * 1024 + F.lane * 16), (LAS unsigned*)(F.lds + RSTD_OFF + p * 1024), 16, 0, 0); }
    if (F.tid == 0) { LAS int* w = (LAS int*)(F.lds + MISC_OFF + 80); int neg = -1; asm volatile("" : "+v"(neg)); w[0] = u.pm; w[1] = neg; }
    return u.pm;
}
__device__ __forceinline__ void ph3_gate(Frame& F, int l) {
    const float* kmean = (const float*)(F.ws + WS_KMEAN);
    const bf16* Q = (const bf16*)(F.ws + WS_Q);
    gu32* cnt = F.ctl + CW_CNT + l * 512; unsigned* list = (unsigned*)(F.ws + WS_LIST);
    const int lane = F.lane, r32 = lane & 31, hh = lane >> 5;
    LAS int* hist = (LAS int*)(F.lds + XTRA_OFF); LAS int* base = hist + 64;
    LAS float* kml = (LAS float*)(F.lds + RING_OFF);
    for (int it0 = F.vcu; it0 < BATCH * NH * NBLK; it0 += 2 * F.G) {
        f32x16 p[2]; int bqv[2], bhv[2], tv[2]; bool act[2];
        __syncthreads();
#pragma unroll
        for (int i = 0; i < 2; ++i) { const int it = it0 + i * F.G; const bool a_ = it < BATCH * NH * NBLK && (it & 31) != 0; const int bh = (a_ ? it : 1) >> 5;
            const int row = F.tid >> 4, c = F.tid & 15; const float* src = kmean + ((size_t)bh * NBLK + row) * HD + 8 * c;
            const f32x4 v0 = *(const GAS f32x4*)src, v1 = *(const GAS f32x4*)(src + 4);
            LAS float* d = kml + i * (NBLK * 132) + row * 132 + 8 * c; *(LAS f32x4*)d = v0; *(LAS f32x4*)(d + 4) = v1; }
        __syncthreads();
#pragma unroll
        for (int i = 0; i < 2; ++i) {
            const int it = it0 + i * F.G; act[i] = it < BATCH * NH * NBLK && (it & 31) != 0;
            const int itc = act[i] ? it : 1;
            const int bq = itc & 31, bh = itc >> 5, b = bh >> 3, h = bh & 7;
            bqv[i] = bq; bhv[i] = bh; tv[i] = bq * MOBA + F.wave * 32 + r32;
            const bf16* qrow = Q + ((size_t)b * SEQ + tv[i]) * DM + h * HD;
            const LAS float* kmr = kml + i * (NBLK * 132) + r32 * 132;
            p[i] = (f32x16){0.f, 0.f, 0.f, 0.f, 0.f, 0.f, 0.f, 0.f, 0.f, 0.f, 0.f, 0.f, 0.f, 0.f, 0.f, 0.f};
            if (act[i]) {
#pragma unroll
                for (int ds = 0; ds < 8; ++ds) {
                    const bf16x8 qf = *(const GAS bf16x8*)(qrow + 16 * ds + 8 * hh);
                    const f32x4 k0 = *(const LAS f32x4*)(kmr + 16 * ds + 8 * hh), k1 = *(const LAS f32x4*)(kmr + 16 * ds + 8 * hh + 4);
                    v4u hi, lo;
                    hi.x = cvt_pk_bf16(k0.x, k0.y); hi.y = cvt_pk_bf16(k0.z, k0.w); hi.z = cvt_pk_bf16(k1.x, k1.y); hi.w = cvt_pk_bf16(k1.z, k1.w);
                    lo.x = cvt_pk_bf16(k0.x - bf_lo(hi.x), k0.y - bf_hi(hi.x)); lo.y = cvt_pk_bf16(k0.z - bf_lo(hi.y), k0.w - bf_hi(hi.y));
                    lo.z = cvt_pk_bf16(k1.x - bf_lo(hi.z), k1.y - bf_hi(hi.z)); lo.w = cvt_pk_bf16(k1.z - bf_lo(hi.w), k1.w - bf_hi(hi.w));
                    p[i] = __builtin_amdgcn_mfma_f32_32x32x16_bf16(__builtin_bit_cast(bf16x8, hi), qf, p[i], 0, 0, 0);
                    p[i] = __builtin_amdgcn_mfma_f32_32x32x16_bf16(__builtin_bit_cast(bf16x8, lo), qf, p[i], 0, 0, 0);
                }
            }
#pragma unroll
            for (int r = 0; r < 16; ++r) if ((r & 3) + 8 * (r >> 2) + 4 * hh >= bq) p[i][r] = -INFINITY;
        }
        __syncthreads();
        if (F.tid < 64) hist[F.tid] = 0;
        __syncthreads();
        int pn[2][3], pp[2][3];
#pragma unroll
        for (int i = 0; i < 2; ++i) { const int nv = act[i] ? (bqv[i] < 3 ? bqv[i] : 3) : 0;
#pragma unroll
            for (int rk = 0; rk < 3; ++rk) { pn[i][rk] = -1; pp[i][rk] = 0; if (rk < nv) {
                float best = -INFINITY; int bi = 64;
#pragma unroll
                for (int r = 0; r < 16; ++r) { const int n = (r & 3) + 8 * (r >> 2) + 4 * hh; if (p[i][r] > best) { best = p[i][r]; bi = n; } }
                const float ob = __shfl_xor(best, 32); const int oi = __shfl_xor(bi, 32);
                if (ob > best || (ob == best && oi < bi)) { best = ob; bi = oi; }
#pragma unroll
                for (int r = 0; r < 16; ++r) if ((r & 3) + 8 * (r >> 2) + 4 * hh == bi) p[i][r] = -INFINITY;
                pn[i][rk] = bi; if (hh == 0) pp[i][rk] = atomicAdd((int*)(hist + i * 32 + bi), 1); } } }
        __syncthreads();
        if (F.tid < 64) { const int i = F.tid >> 5, n = F.tid & 31; const int c = hist[F.tid]; const int bh = i ? bhv[1] : bhv[0];
            base[F.tid] = c ? (int)__hip_atomic_fetch_add(cnt + bh * NBLK + n, (unsigned)c, RLX_AGENT) : 0; }
        __syncthreads();
        if (hh == 0) {
#pragma unroll
            for (int i = 0; i < 2; ++i) { const int nv = act[i] ? (bqv[i] < 3 ? bqv[i] : 3) : 0;
#pragma unroll
                for (int rk = 0; rk < 3; ++rk) if (rk < nv) list[(size_t)(bhv[i] * NBLK + pn[i][rk]) * SEQ + base[i * 32 + pn[i][rk]] + pp[i][rk]] = (unsigned)tv[i] | ((unsigned)rk << 13); }
        }
    }
}

__device__ __forceinline__ int koff(int r, int c) { return r * 256 + ((c ^ (r & 15)) << 4); }
__device__ __forceinline__ int voff(int r, int c) { return r * 256 + ((((c >> 2) ^ (r & 3)) << 6) | ((c & 3) << 4)); }
__device__ __forceinline__ void load_kv_block(Frame& F, const bf16* K, const bf16* V, size_t row0, int h) {
    LAS unsigned char* lk = F.lds + RING_OFF;
    int lane = F.lane; asm volatile("" : "+v"(lane));
    const int rl = lane >> 4, pos = lane & 15;
    const char* kb = (const char*)(K + row0 * DM + h * HD); const char* vb = (const char*)(V + row0 * DM + h * HD);
#pragma unroll
    for (int i = 0; i < 8; ++i) {
        const int p = F.wave + 8 * i, r = 4 * p + rl;
        const unsigned ksrc = (unsigned)(r * (DM * 2) + ((pos ^ (r & 15)) << 4));
        const unsigned vsrc = (unsigned)(r * (DM * 2) + (((((pos >> 2) ^ (r & 3)) << 2) | (pos & 3)) << 4));
        __builtin_amdgcn_global_load_lds((const GAS unsigned*)(kb + ksrc), (LAS unsigned*)(lk + p * 1024), 16, 0, 0);
        __builtin_amdgcn_global_load_lds((const GAS unsigned*)(vb + vsrc), (LAS unsigned*)(lk + 65536 + p * 1024), 16, 0, 0);
    }
    asm volatile("s_waitcnt vmcnt(0)" ::: "memory");
    __syncthreads();
}
__device__ __forceinline__ void sm_tile(f32x16& p, bool dg, int hh, int r32, float& ls, bf16x8& pa0, bf16x8& pa1) {
#pragma unroll
    for (int r = 0; r < 16; ++r) { float e = __builtin_amdgcn_exp2f(p[r]); if (dg && ((r & 3) + 8 * (r >> 2) + 4 * hh) > r32) e = 0.f; p[r] = e; ls += e; }
    v4u pw0, pw1;
    pw0.x = cvt_pk_bf16(p[0], p[1]); pw0.y = cvt_pk_bf16(p[2], p[3]); pw0.z = cvt_pk_bf16(p[4], p[5]); pw0.w = cvt_pk_bf16(p[6], p[7]);
    pw1.x = cvt_pk_bf16(p[8], p[9]); pw1.y = cvt_pk_bf16(p[10], p[11]); pw1.z = cvt_pk_bf16(p[12], p[13]); pw1.w = cvt_pk_bf16(p[14], p[15]);
    pa0 = __builtin_bit_cast(bf16x8, pw0); pa1 = __builtin_bit_cast(bf16x8, pw1);
}
template <bool DIAG, bool OT>
__device__ __forceinline__ void attn_core(LAS unsigned char* lds, const bf16x8 (&qf)[8], int ntiles, f32x16 (&o)[4], float& ls, int lane) {
    const int r32 = lane & 31, hh = lane >> 5;
    const int kbase = r32 * 256, kx = r32 & 15;
    const int q_ = (lane & 15) >> 2, p_ = lane & 3, g1 = (lane >> 4) & 1;
    int vb[4];
#pragma unroll
    for (int d = 0; d < 4; ++d) vb[d] = 65536 + (4 * hh + q_) * 256 + ((d ^ q_) << 6) + 32 * g1 + 8 * p_;
#define SB() __builtin_amdgcn_sched_barrier(0)
#define LOADK(KT) { const LAS unsigned char* kp_ = lds + (KT) * 8192 + kbase; _Pragma("unroll") for (int ds = 0; ds < 8; ++ds) kf[ds] = *(const LAS bf16x8*)(kp_ + (((2 * ds + hh) ^ kx) << 4)); }
#define QKM(P) { P = (f32x16){0.f, 0.f, 0.f, 0.f, 0.f, 0.f, 0.f, 0.f, 0.f, 0.f, 0.f, 0.f, 0.f, 0.f, 0.f, 0.f}; _Pragma("unroll") for (int ds = 0; ds < 8; ++ds) P = __builtin_amdgcn_mfma_f32_32x32x16_bf16(kf[ds], qf[ds], P, 0, 0, 0); }
#define LOADV(VF, KT, D0) { _Pragma("unroll") for (int dd = 0; dd < 2; ++dd) _Pragma("unroll") for (int s2 = 0; s2 < 2; ++s2) { const LAS unsigned char* vp_ = lds + (KT) * 8192 + vb[(D0) + dd] + s2 * 4096; \
        const v4i16_t lo_ = __builtin_amdgcn_ds_read_tr16_b64_v4i16((LAS v4i16_t*)vp_); const v4i16_t hi_ = __builtin_amdgcn_ds_read_tr16_b64_v4i16((LAS v4i16_t*)(vp_ + 2048)); \
        VF[dd * 2 + s2] = (bf16x8){lo_[0], lo_[1], lo_[2], lo_[3], hi_[0], hi_[1], hi_[2], hi_[3]}; } }
#define PVM(VF, D0) { _Pragma("unroll") for (int dd = 0; dd < 2; ++dd) { o[(D0) + dd] = __builtin_amdgcn_mfma_f32_32x32x16_bf16(OT ? VF[dd * 2] : pa0, OT ? pa0 : VF[dd * 2], o[(D0) + dd], 0, 0, 0); o[(D0) + dd] = __builtin_amdgcn_mfma_f32_32x32x16_bf16(OT ? VF[dd * 2 + 1] : pa1, OT ? pa1 : VF[dd * 2 + 1], o[(D0) + dd], 0, 0, 0); } }
    bf16x8 kf[8];
    LOADK(0)
    f32x16 pn; QKM(pn)
    if (ntiles > 1) LOADK(1)
    for (int kt = 0; kt < ntiles; ++kt) {
        const bool last = kt + 1 >= ntiles;
        f32x16 p = pn;
        bf16x8 va[4], vc[4], pa0, pa1;
        LOADV(va, kt, 0)
        SB();
        if (!last) QKM(pn)
        sm_tile(p, DIAG && last, hh, r32, ls, pa0, pa1);
        LOADV(vc, kt, 2)
        SB();
        PVM(va, 0)
        if (kt + 2 < ntiles) LOADK(kt + 2)
        SB();
        PVM(vc, 2)
    }
#undef SB
#undef LOADK
#undef QKM
#undef LOADV
#undef PVM
}
constexpr int STG_ROW = 272, STG_WAVE = 8 * STG_ROW;
__device__ __forceinline__ void stage_round(LAS unsigned char* stg, const f32x16 (&o)[4], int k, int lane, v4u (&pc)[2]) {
    const int r32 = lane & 31, hh = lane >> 5;
#pragma unroll
    for (int rr = 0; rr < 4; ++rr)
#pragma unroll
        for (int d = 0; d < 4; ++d) *(LAS unsigned short*)(stg + (rr + 4 * hh) * STG_ROW + (32 * d + r32) * 2) = (unsigned short)(cvt_pk_bf16(o[d][4 * k + rr], 0.f) & 0xffffu);
    LDS_WAIT(); asm volatile("" ::: "memory");
#pragma unroll
    for (int j = 0; j < 2; ++j) { const int sl = lane + 64 * j; pc[j] = *(const LAS v4u*)(stg + (sl >> 4) * STG_ROW + (sl & 15) * 16); }
    LDS_WAIT(); asm volatile("" ::: "memory");
}
__device__ __forceinline__ void ph4_sparse(Frame& F, int l) {
    const bf16* Q = (const bf16*)(F.ws + WS_Q); const bf16* K = (const bf16*)(F.ws + WS_K); const bf16* V = (const bf16*)(F.ws + WS_V);
    bf16* PART = (bf16*)(F.ws + WS_PART); float* LP = (float*)(F.ws + WS_LPART);
    const unsigned* list = (const unsigned*)(F.ws + WS_LIST); gu32* cnt = F.ctl + CW_CNT + l * 512;
    LAS int* pre = (LAS int*)(F.lds + XTRA_OFF);
    LAS unsigned* ent = (LAS unsigned*)(F.lds + XTRA_OFF + 4096) + F.wave * 32;
    const int lane = F.lane, r32 = lane & 31, hh = lane >> 5;
    constexpr int LOADW = 5;
    const int myc = (int)__hip_atomic_load(cnt + F.tid, RLX_AGENT);
    { int v = myc ? LOADW + 8 * ((myc + 255) >> 8) : 0;
#pragma unroll
      for (int off = 1; off < 64; off <<= 1) { const int t = __shfl_up(v, off); if (lane >= off) v += t; }
      LAS int* wsum = pre + 512;
      if (lane == 63) wsum[F.wave] = v;
      __syncthreads();
      int base = 0;
#pragma unroll
      for (int w = 0; w < NWAVES - 1; ++w) base += (w < F.wave) ? wsum[w] : 0;
      pre[F.tid] = v + base;
      __syncthreads(); }
    const int T = pre[511];
    const int lo = (int)(((long)F.vcu * T) / F.G), hi = (int)(((long)(F.vcu + 1) * T) / F.G);
    LAS unsigned char* stg = F.lds + STG_OFF + F.wave * STG_WAVE;
    int it = lo;
    while (it < hi) {
        int a = 0, bnd = 511;
        while (a < bnd) { const int mid = (a + bnd) >> 1; if (pre[mid] > it) bnd = mid; else a = mid + 1; }
        const int bhn = a, first = bhn ? pre[bhn - 1] : 0, cost = pre[bhn] - first, R = (cost - LOADW) >> 3;
        const int pa = it - first, pb = (hi < pre[bhn] ? hi : pre[bhn]) - first;
        it = first + pb;
        int ra = (pa - LOADW + 7) >> 3; ra = ra < 0 ? 0 : ra; int rb = (pb - LOADW + 7) >> 3; rb = rb < 0 ? 0 : (rb > R ? R : rb);
        if (pb == cost) rb = R;
        if (rb <= ra) continue;
        const int bh = bhn >> 5, n = bhn & 31, b = bh >> 3, h = bh & 7;
        const int c_tot = (int)__hip_atomic_load(cnt + bhn, RLX_AGENT);
        PSUB_BEGIN(200);
        __syncthreads();
        load_kv_block(F, K, V, (size_t)b * SEQ + n * MOBA, h);
        PSUB_END(200);
        const int s1 = (c_tot + 31) >> 5;
        const int send = 8 * rb < s1 ? 8 * rb : s1;
        const unsigned* lst = list + (size_t)bhn * SEQ;
        const bf16* Qh = Q + (size_t)b * SEQ * DM + h * HD + 8 * hh;
        for (int sc = 8 * ra + F.wave; sc < send; sc += NWAVES) {
            const int idx = sc * 32 + r32;
            const unsigned e = idx < c_tot ? lst[idx] : 0xffffffffu;
            const bool valid = e != 0xffffffffu;
            const size_t qr = valid ? (e & 8191u) : 0u;
            bf16x8 qf[8];
#pragma unroll
            for (int ds = 0; ds < 8; ++ds) qf[ds] = *(const GAS bf16x8*)(Qh + qr * DM + 16 * ds);
            f32x16 o[4];
#pragma unroll
            for (int d = 0; d < 4; ++d)
#pragma unroll
                for (int r = 0; r < 16; ++r) o[d][r] = 0.f;
            float ls = 0.f;
            PSUB_BEGIN(202);
            attn_core<false, true>(F.lds + RING_OFF, qf, 8, o, ls, lane);
            PSUB_END(202); PSUB_BEGIN(203);
            ls += __shfl_xor(ls, 32);
            if (valid && hh == 0) LP[((size_t)(e >> 13) * M + (size_t)b * SEQ + qr) * NH + h] = ls;
            char* prow = (char*)(PART + ((size_t)(valid ? (e >> 13) : 0u) * M + (size_t)b * SEQ + qr) * DM + h * HD) + 16 * hh;
#pragma unroll
            for (int d = 0; d < 4; ++d)
#pragma unroll
                for (int jj = 0; jj < 2; ++jj) {
                    unsigned ax = cvt_pk_bf16(o[d][8 * jj + 0], o[d][8 * jj + 1]), ay = cvt_pk_bf16(o[d][8 * jj + 2], o[d][8 * jj + 3]);
                    unsigned bx = cvt_pk_bf16(o[d][8 * jj + 4], o[d][8 * jj + 5]), by = cvt_pk_bf16(o[d][8 * jj + 6], o[d][8 * jj + 7]);
                    { auto r = __builtin_amdgcn_permlane32_swap(ax, bx, false, false); ax = r[0]; bx = r[1]; }
                    { auto r = __builtin_amdgcn_permlane32_swap(ay, by, false, false); ay = r[0]; by = r[1]; }
                    if (valid) *(GAS v4u*)(prow + 32 * (2 * d + jj)) = (v4u){ax, ay, bx, by};
                }
            PSUB_END(203);
        }
    }
}

__device__ __forceinline__ void ph5_diag(Frame& F, int l, int own_pm, int own_hp) {
    bf16* Q = (bf16*)(F.ws + WS_Q); const bf16* K = (const bf16*)(F.ws + WS_K); const bf16* V = (const bf16*)(F.ws + WS_V);
    const bf16* PART = (const bf16*)(F.ws + WS_PART); const float* LP = (const float*)(F.ws + WS_LPART);
    LAS float* lsh = (LAS float*)(F.lds + XTRA_OFF) + F.wave * 32;
    LAS unsigned char* stg = F.lds + STG_OFF + F.wave * STG_WAVE;
    const int it_beg = own_pm >= 0 ? (((own_pm >> 5) * NH + 2 * own_hp) * NBLK + (own_pm & 31)) : F.vcu, it_step = own_pm >= 0 ? NBLK : F.G, it_end = own_pm >= 0 ? it_beg + 2 * NBLK : BATCH * NH * NBLK;
    for (int it = it_beg; it < it_end; it += it_step) {
        int lane = F.lane; asm volatile("" : "+v"(lane));
        const int r32 = lane & 31, hh = lane >> 5;
        const int bq = it & 31, bh = it >> 5, b = bh >> 3, h = bh & 7;
        const size_t row0 = (size_t)b * SEQ + bq * MOBA;
        const int sb = F.wave < 4 ? 7 - F.wave : F.wave - 4;
        const size_t qrow = row0 + sb * 32 + r32;
        bf16x8 qf[8];
#pragma unroll
        for (int ds = 0; ds < 8; ++ds) qf[ds] = *(const GAS bf16x8*)(Q + qrow * DM + h * HD + 16 * ds + 8 * hh);
        const int nv = bq < 3 ? bq : 3;
        float lsum_part = 0.f;
        for (int j = 0; j < nv; ++j) lsum_part += LP[((size_t)j * M + qrow) * NH + h];
        PSUB_BEGIN(210);
        __syncthreads();
        load_kv_block(F, K, V, row0, h);
        PSUB_END(210); PSUB_BEGIN(211);
        f32x16 o[4];
#pragma unroll
        for (int d = 0; d < 4; ++d)
#pragma unroll
            for (int r = 0; r < 16; ++r) o[d][r] = 0.f;
        float ls = 0.f;
        attn_core<true, false>(F.lds + RING_OFF, qf, sb + 1, o, ls, lane);
        asm volatile("" ::: "memory"); __builtin_amdgcn_sched_barrier(0);
        PSUB_END(211); PSUB_BEGIN(212);
        ls += __shfl_xor(ls, 32);
        ls += lsum_part;
        if (hh == 0) lsh[r32] = 1.f / ls;
        const bf16* pbase = PART + (row0 + sb * 32) * DM + h * HD;
        v4u pl[2][3][2];
#define PL_LOAD(buf, k) _Pragma("unroll") for (int s3 = 0; s3 < 3; ++s3) _Pragma("unroll") for (int j = 0; j < 2; ++j) { const int sl = lane + 64 * j; \
            pl[buf][s3][j] = (v4u){0u, 0u, 0u, 0u}; if (s3 < nv) pl[buf][s3][j] = *(const GAS v4u*)(pbase + (size_t)s3 * M * DM + (size_t)(8 * (k) + (sl >> 4)) * DM + 8 * (sl & 15)); }
        PL_LOAD(0, 0)
#pragma unroll
        for (int k = 0; k < 4; ++k) {
            if (k == 0) { PL_LOAD(1, 1) } else if (k == 1) { PL_LOAD(0, 2) } else if (k == 2) { PL_LOAD(1, 3) }
            v4u pc[2]; stage_round(stg, o, k, lane, pc);
#pragma unroll
            for (int j = 0; j < 2; ++j) { const int sl = lane + 64 * j, ql = 8 * k + (sl >> 4); const size_t rw = row0 + sb * 32 + ql;
                pg8::f32x4 a0, a1; pg8::unpack8(pc[j], a0, a1);
#pragma unroll
                for (int s3 = 0; s3 < 3; ++s3) { pg8::f32x4 b0, b1; pg8::unpack8(pl[k & 1][s3][j], b0, b1); a0 += b0; a1 += b1; }
                const float inv = lsh[ql];
                *(GAS v4u*)(Q + rw * DM + h * HD + 8 * (sl & 15)) = pg8::pack8(a0 * inv, a1 * inv); }
        }
#undef PL_LOAD
        PSUB_END(212);
    }
}

__device__ __forceinline__ void ph7_conv(Frame& F, int l) {
    const bf16* GLU = (const bf16*)(F.ws + WS_GLU); const bf16* SZC = (const bf16*)(F.ws + WS_SZC); bf16* C = (bf16*)(F.ws + WS_AC) + DM;
    const float* cw = ARG_IN(6) + (size_t)l * CK * DM; const float* cb = ARG_IN(7) + (size_t)l * DM; const float* cg = ARG_IN(8) + (size_t)l * DM; const float* cbeta = ARG_IN(9) + (size_t)l * DM;
    LAS unsigned* tile = (LAS unsigned*)(F.lds + RING_OFF);
    LAS float* red = (LAS float*)(F.lds + XTRA_OFF);
    LAS float* stat = red + 512;
    const int tid = F.tid, lane = F.lane;
    constexpr int TT = 8;
    float w0[CK], w1[CK];
#pragma unroll
    for (int j = 0; j < CK; ++j) { const f32x2v wv = *(const GAS f32x2v*)(cw + (size_t)j * DM + 2 * tid); w0[j] = wv.x; w1[j] = wv.y; }
    const f32x2v bv = *(const GAS f32x2v*)(cb + 2 * tid), gv = *(const GAS f32x2v*)(cg + 2 * tid), bev = *(const GAS f32x2v*)(cbeta + 2 * tid);
    for (int it = F.vcu; it < M / 32; it += F.G) {
        const int tok0 = it * 32, t0 = tok0 & (SEQ - 1);
        __syncthreads();
        PSUB_BEGIN(100);
        {
            const int zr = t0 < 30 ? 30 - t0 : 0;
            const char* src = (const char*)(GLU + (size_t)(tok0 - 30) * DM);
#pragma unroll 4
            for (int p = F.wave; p < 124; p += NWAVES) {
                if (2 * zr > p) { *(LAS v4u*)((LAS unsigned char*)tile + p * 1024 + lane * 16) = (v4u){0u, 0u, 0u, 0u}; }
                else __builtin_amdgcn_global_load_lds((const GAS unsigned*)(src + (size_t)p * 1024 + lane * 16), (LAS unsigned*)((LAS unsigned char*)tile + p * 1024), 16, 0, 0);
            }
            asm volatile("s_waitcnt vmcnt(0)" ::: "memory");
        }
        __syncthreads();
        PSUB_END(100); PSUB_BEGIN(101);
        float a0[32], a1[32];
#pragma unroll
        for (int hf = 0; hf < 32 / TT; ++hf) {
#pragma unroll
            for (int tt = 0; tt < TT; ++tt) { a0[hf * TT + tt] = bv.x; a1[hf * TT + tt] = bv.y; }
#pragma unroll
            for (int i = 0; i < TT + 30; ++i) { const unsigned w = tile[(hf * TT + i) * 512 + tid]; const float x0 = bf_lo(w), x1 = bf_hi(w);
#pragma unroll
                for (int tt = 0; tt < TT; ++tt) if (i - tt >= 0 && i - tt < CK) { a0[hf * TT + tt] += w0[i - tt] * x0; a1[hf * TT + tt] += w1[i - tt] * x1; }
                if ((i & 7) == 7) __builtin_amdgcn_sched_barrier(0); }
            float rv[2 * TT];
#pragma unroll
            for (int tt = 0; tt < TT; ++tt) { const float p0 = a0[hf * TT + tt], p1 = a1[hf * TT + tt]; rv[2 * tt] = p0 + p1; rv[2 * tt + 1] = p0 * p0 + p1 * p1; }
#define TR_STEP(MM) { const bool up = (lane & (MM)) != 0; _Pragma("unroll") for (int i = 0; i < (MM); ++i) { const float send = up ? rv[i] : rv[i + (MM)], keep = up ? rv[i + (MM)] : rv[i]; rv[i] = keep + __shfl_xor(send, (MM)); } }
            static_assert(TT == 8, "transpose-reduce steps are written out for 16 values");
            TR_STEP(8) TR_STEP(4) TR_STEP(2) TR_STEP(1)
#undef TR_STEP
            rv[0] += __shfl_xor(rv[0], 16); rv[0] += __shfl_xor(rv[0], 32);
            if (lane < 2 * TT) red[F.wave * 64 + hf * 2 * TT + lane] = rv[0];
            __builtin_amdgcn_sched_barrier(0);
        }
        unsigned z[32];
#pragma unroll
        for (int tt = 0; tt < 32; ++tt) z[tt] = *((const GAS unsigned*)(SZC + (size_t)(tok0 + tt) * DM) + tid);
        __syncthreads();
        if (tid < 64) { float s = 0.f;
#pragma unroll
            for (int w = 0; w < 8; ++w) s += red[w * 64 + tid];
            const float other = __shfl_xor(s, 1);
            const float mean = ((tid & 1) ? other : s) * (1.f / DM), ex2 = ((tid & 1) ? s : other) * (1.f / DM);
            const float var = fmaxf(ex2 - mean * mean, 0.f);
            stat[tid] = (tid & 1) ? 1.f / sqrtf(var + EPS) : mean; }
        __syncthreads();
        PSUB_END(101); PSUB_BEGIN(102);
#pragma unroll
        for (int tt = 0; tt < 32; ++tt) {
            const float mean = stat[2 * tt], rstd = stat[2 * tt + 1];
            const float y0 = (a0[tt] - mean) * rstd * gv.x + bev.x, y1 = (a1[tt] - mean) * rstd * gv.y + bev.y;
            *((GAS unsigned*)(C + (size_t)(tok0 + tt) * (2 * DM)) + tid) = cvt_pk_bf16(silu(y0) * bf_lo(z[tt]), silu(y1) * bf_hi(z[tt]));
        }
        PSUB_END(102);
    }
}

#ifndef ONLY_PHASE
#define ONLY_PHASE -1
#endif
#ifndef ONLY_SUB
#define ONLY_SUB 0
#endif
#define SUB(k) (ONLY_SUB == 0 || ONLY_SUB == (k))
#ifndef STAG6
#define STAG6 0u
#endif
#define ONLY(k) (ONLY_PHASE < 0 || ONLY_PHASE == (k))
__global__ void __launch_bounds__(NWAVES * 64, 2) hybrid_fwd(Args args) {
    extern __shared__ __attribute__((aligned(16))) unsigned char lds[];
    Frame F;
    F.lds = (LAS unsigned char*)lds;
    F.MISC = (volatile LAS unsigned*)(F.lds + MISC_OFF);
    F.tid = threadIdx.x; F.lane = F.tid & 63; F.wave = __builtin_amdgcn_readfirstlane(F.tid >> 6);
    F.G = gridDim.x; { const int bx = blockIdx.x; F.vcu = (F.G % 8 == 0) ? (bx % 8) * (F.G / 8) + bx / 8 : bx; }
    F.ws = args.ws; F.ctl = (gu32*)(args.ws + WS_CTL);
    for (int u = F.tid; u < (LDS_BYTES - LDSCTL_OFF) / 4; u += NWAVES * 64) ((LAS unsigned*)(F.lds + LDSCTL_OFF))[u] = 0u;
    __syncthreads();
    XcdBarrier bar; bar.bar = (unsigned*)(F.ctl + CW_BAR); bar.x = 0; bar.st = nullptr;
#if !MK_PER_PHASE
    bar = xcd_barrier_post((unsigned*)(F.ctl + CW_BAR), F.MISC + 8);
#endif
#if MK_PER_PHASE
#define GRID_BAR() do { } while (0)
#else
#define GRID_BAR() xcd_barrier(bar)
#endif
    const int lo = args.ph_lo, hi = args.ph_hi;
    unsigned long long probe_t0 = 0, probe_acc = 0; F.pacc = 0; F.pt0 = 0; unsigned pt32 = 0; unsigned long long clk_t0 = 0, clk_c0 = 0, clk_t = 0, clk_c = 0;
#define WT ((bf16*)(F.ws + WS_WT))
#define XN ((bf16*)(F.ws + WS_XN))
#define Qb ((bf16*)(F.ws + WS_Q))
#define GA ((bf16*)(F.ws + WS_GA))
#define GLU ((bf16*)(F.ws + WS_GLU))
#define SZC ((bf16*)(F.ws + WS_SZC))
#define GC ((bf16*)(F.ws + WS_GC))
#define ACb ((bf16*)(F.ws + WS_AC))
#define MB ((bf16*)(F.ws + WS_MB))
#define PH_BEGIN(k) if (ONLY(k) && lo <= l * NPHASE_L + (k) && l * NPHASE_L + (k) < hi) { { int t_ = threadIdx.x; asm volatile("" : "+v"(t_)); F.tid = t_; F.lane = t_ & 63; F.wave = __builtin_amdgcn_readfirstlane(t_ >> 6); GAS unsigned char* w_ = (GAS unsigned char*)args.ws; asm volatile("" : "+s"(w_)); F.ws = (unsigned char*)w_; F.ctl = (gu32*)(w_ + WS_CTL); } if (PROBE_PHASE == (k)) probe_t0 = rt(); if (PROBE_PHASE == 700 + (k)) pt32 = (unsigned)rt(); if (PROBE_PHASE == 600 + (k)) { clk_t0 = rt(); clk_c0 = __builtin_amdgcn_s_memtime(); }
#define PH_END_NOBAR(k) if (PROBE_PHASE == (k)) { const unsigned long long t1_ = rt(); probe_acc += t1_ - probe_t0; } if (PROBE_PHASE == 600 + (k)) { clk_t += rt() - clk_t0; clk_c += __builtin_amdgcn_s_memtime() - clk_c0; } }
#define PH_END(k) if (PROBE_PHASE == 700 + (k)) { if (F.tid == 0) atomicMax((unsigned*)(F.ctl + 96), (unsigned)rt() - pt32); } if (l * NPHASE_L + (k) + 1 < hi) GRID_BAR(); if (PROBE_PHASE == 500 && l * NPHASE_L + (k) + 1 < hi) GRID_BAR(); if (PROBE_PHASE == (k)) { const unsigned long long t1_ = rt(); probe_acc += t1_ - probe_t0; } if (PROBE_PHASE == 600 + (k)) { clk_t += rt() - clk_t0; clk_c += __builtin_amdgcn_s_memtime() - clk_c0; } }
#pragma unroll 1
    for (int l = 0; l < DEPTH; ++l) {
        PH_BEGIN(0) { ph0_prologue(F, l, (l == 0) ? ARG_IN(0) : (const float*)ARG_OUT); }
        PH_END(0)
        PH_BEGIN(1) { (void)prefetch_ss_panel(F, 3072); pg8::Gemm g{XN, WT + WT_B * DM, M, 3072, DM}; pg8::StaticOrder S; S.init(M, 3072, F.G, (int)blockIdx.x);
            pg8::EpiQKV E{Qb, (size_t)(WS_K - WS_Q) / 2, ARG_IN(4) + (size_t)l * HD, ARG_IN(5) + (size_t)l * HD, (const unsigned short*)(F.ws + WS_ROPE),
                          (float*)(F.ws + WS_KMEAN), QSCALE, F.lds + XTRA_OFF, SEQ, pg8::RowRstd{(LAS float*)(F.lds + RSTD_OFF), (LAS float*)(F.lds + RTAB_OFF), (LAS int*)(F.lds + MISC_OFF + 80), (const float*)(F.ws + WS_SS)}};
            pg8::gemm_phase<pg8::EpiQKV, pg8::StaticOrder, true, PG8_SP2>(F.lds + RING_OFF, g, S, E); }
        PH_END(1)
        PH_BEGIN(3) { ph3_gate(F, l); }
        PH_END(3)
        PH_BEGIN(4) { ph4_sparse(F, l); }
        PH_END(4)
        PH_BEGIN(5) { if (F.G != 256) { ph5_diag(F, l, -1, 0); GRID_BAR(); } }
        PH_END_NOBAR(5)
        PH_BEGIN(6) { if (F.G == 256) { int bx = blockIdx.x; asm volatile("" : "+s"(bx)); pg8::StaticOrder S0; S0.init(M, 6144, F.G, bx); pg8::Unit u0; (void)S0.next(0, u0);
                ph5_diag(F, l, u0.pm, u0.pn & 3); asm volatile("s_waitcnt vmcnt(0)" ::: "memory"); __syncthreads();
                if (F.tid == 0) (void)__hip_atomic_fetch_add(F.ctl + CW_DDONE + l * 64, 1u, __ATOMIC_RELAXED, __HIP_MEMORY_SCOPE_AGENT); }
            (void)prefetch_ss_panel(F, 6144); pg8::Gemm g{XN, WT + WT_C * DM, M, 6144, DM}; pg8::StaticOrder S; S.init(M, 6144, F.G, (int)blockIdx.x);
            pg8::EpiCA E{pg8::EpiC{Qb, ACb, GA, ARG_IN(3) + (size_t)l * 2 * DM}, pg8::EpiA{GLU, SZC, GC, ARG_IN(3) + (size_t)l * 2 * DM + DM}, pg8::RowRstd{(LAS float*)(F.lds + RSTD_OFF), (LAS float*)(F.lds + RTAB_OFF), (LAS int*)(F.lds + MISC_OFF + 80), (const float*)(F.ws + WS_SS)}, F.ctl + CW_DDONE + l * 64, F.G == 256 ? 256u : 0u};
            pg8::gemm_phase<pg8::EpiCA, pg8::StaticOrder, PG8_ALIGN, PG8_SP2>(F.lds + RING_OFF, g, S, E); }
        PH_END(6)
        PH_BEGIN(7) { ph7_conv(F, l); }
        PH_END(7)
        PH_BEGIN(8) { pg8::Gemm g{ACb, WT + WT_PA * DM, M, DM, 2 * DM}; pg8::StaticOrder S; S.init(M, DM, F.G, (int)blockIdx.x);
            pg8::EpiM E{MB, GA, GC};
            pg8::gemm_phase<pg8::EpiM, pg8::StaticOrder, PG8_ALIGN, PG8_SP2>(F.lds + RING_OFF, g, S, E); }
        PH_END(8)
        PH_BEGIN(9) { pg8::Gemm g{MB, l == 0 ? WT + WT_O * DM : (bf16*)(F.ws + WS_WO1), M, DM, DM}; pg8::StaticOrder S; S.init(M, DM, F.G, (int)blockIdx.x);
            pg8::EpiOut E{(l == 0) ? ARG_IN(0) : (const float*)ARG_OUT, ARG_OUT, (l + 1 < DEPTH) ? XN : (bf16*)nullptr, ARG_IN(1) + (size_t)(l + 1 < DEPTH ? l + 1 : l) * DM, (float*)(F.ws + WS_SS)};
            pg8::gemm_phase<pg8::EpiOut, pg8::StaticOrder, PG8_ALIGN, PG8_SP2>(F.lds + RING_OFF, g, S, E); }
        PH_END_NOBAR(9)
    }
    if (PROBE_PHASE == 400 || PROBE_PHASE == 401) F.pacc += F.MISC[16];
    if (PROBE_PHASE >= 700 && PROBE_PHASE < 800) F.pacc += __hip_atomic_load(F.ctl + 96, RLX_AGENT);
    if (PROBE_PHASE >= 600) F.pacc += (clk_t ? (clk_c * 125ull) / clk_t : 0ull);
    if (PROBE_PHASE >= 0 && blockIdx.x == 0) { const unsigned long long t0_ = rt(); while (rt() - t0_ < 8ull * (probe_acc + F.pacc)) __builtin_amdgcn_s_sleep(8); }
}

extern "C" void kernel_launch(void* const* d_in, const int* in_sizes, int n_in, void* d_out, int out_size, void* d_ws, size_t ws_size, hipStream_t stream) {
    static int grid = 0;
    if (grid == 0) {
        if (n_in != 13 || in_sizes[0] != M * DM || out_size != M * DM || ws_size < WS_END) {
            fprintf(stderr, "kernel_launch: built for 13 inputs, x/out of %d floats, >= %zu bytes of workspace; got n_in %d, in0 %d, out %d, ws %zu; nothing launched\n", M * DM, (size_t)WS_END, n_in, n_in > 0 ? in_sizes[0] : -1, out_size, ws_size);
            grid = -1; return; }
        int dev = 0, cus = 0, per_cu = 0;
        if (hipGetDevice(&dev) != hipSuccess || hipDeviceGetAttribute(&cus, hipDeviceAttributeMultiprocessorCount, dev) != hipSuccess) { fprintf(stderr, "kernel_launch: device query failed\n"); grid = -1; return; }
        if (hipFuncSetAttribute((const void*)hybrid_fwd, hipFuncAttributeMaxDynamicSharedMemorySize, LDS_BYTES) != hipSuccess) { fprintf(stderr, "kernel_launch: hipFuncSetAttribute failed\n"); grid = -1; return; }
        if (hipOccupancyMaxActiveBlocksPerMultiprocessor(&per_cu, (const void*)hybrid_fwd, NWAVES * 64, LDS_BYTES) != hipSuccess || per_cu < 1)
            fprintf(stderr, "kernel_launch: note: occupancy query reports %d workgroups per CU\n", per_cu);
        (void)hipGetLastError();
        grid = cus;
    }
    if (grid < 0) return;
    if (hipMemsetAsync((char*)d_ws + WS_CTL, 0, CTL_ZERO_BYTES, stream) != hipSuccess) { fprintf(stderr, "kernel_launch: hipMemsetAsync failed\n"); return; }
    Args a{};
    for (int i = 0; i < 13; ++i) a.in[i] = (const float*)d_in[i];
    a.out = (float*)d_out; a.ws = (unsigned char*)d_ws;
#if MK_PER_PHASE
    for (int ph = 0; ph < NPHASES; ++ph) { a.ph_lo = ph; a.ph_hi = ph + 1; hipLaunchKernelGGL(hybrid_fwd, dim3(grid), dim3(NWAVES * 64), LDS_BYTES, stream, a); }
#else
    a.ph_lo = 0; a.ph_hi = NPHASES;
    hipLaunchKernelGGL(hybrid_fwd, dim3(grid), dim3(NWAVES * 64), LDS_BYTES, stream, a);
#endif
    const hipError_t le = hipPeekAtLastError();
    if (le != hipSuccess) fprintf(stderr, "kernel_launch: launch failed: %s\n", hipGetErrorName(le));
}
```

```cpp
#include <hip/hip_runtime.h>
#include <cstdio>
#include <cstdint>
namespace pg8 {
#define PG8_LAS __attribute__((address_space(3)))
typedef unsigned short bf16_t;
typedef short bf16x8 __attribute__((ext_vector_type(8)));
typedef float f32x4 __attribute__((ext_vector_type(4)));
typedef unsigned u32x4 __attribute__((ext_vector_type(4)));
constexpr int BM = 256, BK = 64, HALF = 128, HTB = HALF * BK * 2  , STAGE_BYTES = 8 * HTB, NXCD = 8, WGM = 8;

__host__ __device__ __forceinline__ int lds_byte(int r, int c) { const int st = (r >> 4) * 2 + (c >> 5), rr = r & 15, cc = c & 31, ob = rr * 64 + cc * 2; return st * 1024 + (ob ^ (((ob >> 9) & 1) << 5)); }
__host__ __device__ __forceinline__ void stage_rc(int b, int& R, int& C) { const int st = b / 1024, sb = b % 1024, swz = sb ^ (((sb >> 9) & 1) << 5); R = (st >> 1) * 16 + swz / 64; C = (st & 1) * 32 + (swz % 64) / 2; }
__host__ __device__ __forceinline__ int perm32(int rho) { const int n = rho >> 4, i = rho & 15; return 8 * (i >> 2) + 4 * n + (i & 3); }

struct Unit { int pm, pn; };
struct Gemm { const bf16_t* A; const bf16_t* Bt; int M, N, K; };

struct StaticOrder {
    int nM, nN, nwg, G, c;
    __host__ __device__ void init(int M, int N, int G_, int c_) { nM = M / BM; nN = N / BM; nwg = nM * nN; G = G_; c = c_; }
    __host__ __device__ bool next(int i, Unit& u) const {
        const long L = (long)i * G + c; if (L >= nwg) return false;
        int wgid = (int)L; { const int q = nwg / NXCD, r = nwg % NXCD, xcd = wgid % NXCD, off = wgid / NXCD; wgid = (xcd < r ? xcd * (q + 1) : r * (q + 1) + (xcd - r) * q) + off; }
        const int nig = WGM * nN, gid = wgid / nig, fm = gid * WGM, gsz = (nM - fm) < WGM ? (nM - fm) : WGM;
        u.pm = fm + ((wgid % nig) % gsz); u.pn = (wgid % nig) / gsz; return true;
    }
    __device__ __forceinline__ void a_ready(const Unit&) const {}
    __device__ __forceinline__ void done(const Unit&) const {}
};


typedef float f32x2 __attribute__((ext_vector_type(2)));
typedef __bf16 bf16x2_t __attribute__((ext_vector_type(2)));
__device__ __forceinline__ unsigned cvt_pk_bf16(float lo, float hi) { f32x2 v = {lo, hi}; bf16x2_t b = __builtin_convertvector(v, bf16x2_t); return __builtin_bit_cast(unsigned, b); }
__device__ __forceinline__ float bf_lo(unsigned w) { return __builtin_bit_cast(float, w << 16); }
__device__ __forceinline__ float bf_hi(unsigned w) { return __builtin_bit_cast(float, w & 0xffff0000u); }
__device__ __forceinline__ float sigm(float x) { return __builtin_amdgcn_rcpf(1.f + __expf(-x)); }
__device__ __forceinline__ float silu(float x) { return x * sigm(x); }
__device__ __forceinline__ u32x4 pack8(const f32x4 a, const f32x4 b) { u32x4 w; w.x = cvt_pk_bf16(a[0], a[1]); w.y = cvt_pk_bf16(a[2], a[3]); w.z = cvt_pk_bf16(b[0], b[1]); w.w = cvt_pk_bf16(b[2], b[3]); return w; }
__device__ __forceinline__ void unpack8(const u32x4 w, f32x4& a, f32x4& b) { a = (f32x4){bf_lo(w.x), bf_hi(w.x), bf_lo(w.y), bf_hi(w.y)}; b = (f32x4){bf_lo(w.z), bf_hi(w.z), bf_lo(w.w), bf_hi(w.w)}; }

struct EpiBf16 {
    static constexpr bool PERM = true, AFTER_DRAIN = false;
    bf16_t* O; int ldc; int split_cols; size_t split_stride;
    __device__ __forceinline__ void operator()(const f32x4 (&acc)[2][2][4][2], const Unit& u, int wr, int wc, int fr, int fq) const {
        const int row0 = u.pm * BM + wr * 64 + fr; int colt = u.pn * BM; bf16_t* base = O;
        if (split_cols) { const int t = colt / split_cols; base += (size_t)t * split_stride; colt -= t * split_cols; }
        const int col0 = colt + wc * 32 + 8 * fq;
#pragma unroll
        for (int ai = 0; ai < 2; ++ai)
#pragma unroll
            for (int m = 0; m < 4; ++m) { bf16_t* rowp = base + (size_t)(row0 + ai * HALF + m * 16) * ldc + col0;
#pragma unroll
                for (int bj = 0; bj < 2; ++bj) *(u32x4*)(rowp + bj * HALF) = pack8(acc[ai][bj][m][0], acc[ai][bj][m][1]); }
    }
};

struct RowRstd { PG8_LAS float* part; PG8_LAS float* tab; PG8_LAS int* words; const float* ss;
    __device__ __forceinline__ void ensure(int pm, int wid, int lane) const {
        const int have_p = __builtin_amdgcn_readfirstlane(words[0]), have_t = __builtin_amdgcn_readfirstlane(words[1]);
        if (have_t == pm) return;
        asm volatile("s_waitcnt lgkmcnt(0)" ::: "memory"); __builtin_amdgcn_s_barrier(); asm volatile("" ::: "memory");
        if (have_p != pm) {
            const char* src = (const char*)ss + (size_t)pm * 256 * 64;
#pragma unroll
            for (int i = 0; i < 2; ++i) { const int p = wid * 2 + i;
                __builtin_amdgcn_global_load_lds((const __attribute__((address_space(1))) unsigned*)(src + p * 1024 + lane * 16), (PG8_LAS unsigned*)((PG8_LAS char*)part + p * 1024), 16, 0, 0); }
            asm volatile("s_waitcnt vmcnt(0)" ::: "memory"); __builtin_amdgcn_s_barrier(); asm volatile("" ::: "memory");
        }
        const int tid = wid * 64 + lane;
        if (tid < 256) { const PG8_LAS f32x4* p = (const PG8_LAS f32x4*)(part + tid * 16); const f32x4 a = p[0], b = p[1], c = p[2], d = p[3];
            const float s = ((a[0] + a[1]) + (a[2] + a[3])) + ((b[0] + b[1]) + (b[2] + b[3])) + ((c[0] + c[1]) + (c[2] + c[3])) + ((d[0] + d[1]) + (d[2] + d[3]));
            tab[tid] = 1.0f / sqrtf(s * (1.0f / 1024.0f) + 1e-6f); }
        if (tid == 0) { words[0] = pm; words[1] = pm; }
        asm volatile("s_waitcnt lgkmcnt(0)" ::: "memory"); __builtin_amdgcn_s_barrier(); asm volatile("" ::: "memory");
    }
    __device__ __forceinline__ float get(int rl) const { return tab[rl]; } };
struct EpiQKV {
    static constexpr bool PERM = true, AFTER_DRAIN = false;
    bf16_t* Q; size_t split_stride; const float* gq; const float* gk; const unsigned short* rope; float* kmean; float qscale; PG8_LAS unsigned char* xs; int seq; RowRstd rstd;
    __device__ __forceinline__ void operator()(f32x4 (&acc)[2][2][4][2], const Unit& u, int wr, int wc, int fr_in, int fq_in) const {
        int fr = fr_in, fq = fq_in; asm volatile("" : "+v"(fr), "+v"(fq));
        u32x4 tb[2][4];
        if ((u.pn >> 2) != 2 && wc == 0) {
#pragma unroll
            for (int ai = 0; ai < 2; ++ai)
#pragma unroll
                for (int m = 0; m < 4; ++m) { const int row = u.pm * BM + ai * HALF + wr * 64 + m * 16 + fr;
                    tb[ai][m] = *(const u32x4*)((const char*)rope + (unsigned)((row & (seq - 1)) * 64 + (fq >> 1) * 32 + (fq & 1) * 16)); }
        }
        rstd.ensure(u.pm, wr * 4 + wc, fq * 16 + fr);
        { float rs[2][4];
#pragma unroll
          for (int ai = 0; ai < 2; ++ai)
#pragma unroll
            for (int m = 0; m < 4; ++m) rs[ai][m] = rstd.get(ai * HALF + wr * 64 + m * 16 + fr);
#pragma unroll
          for (int ai = 0; ai < 2; ++ai)
#pragma unroll
            for (int m = 0; m < 4; ++m)
#pragma unroll
                for (int bj = 0; bj < 2; ++bj) { acc[ai][bj][m][0] = acc[ai][bj][m][0] * rs[ai][m]; acc[ai][bj][m][1] = acc[ai][bj][m][1] * rs[ai][m]; } }
        const int sect = u.pn >> 2;
        char* base = (char*)(Q + (size_t)sect * split_stride);
        const unsigned off0 = (unsigned)(((u.pm * BM + wr * 64 + fr) * 1024 + (u.pn & 3) * BM + wc * 32 + 8 * fq) * 2);
        if (sect != 2) {
            PG8_LAS float* P = (PG8_LAS float*)xs;
#pragma unroll
            for (int ai = 0; ai < 2; ++ai)
#pragma unroll
                for (int m = 0; m < 4; ++m)
#pragma unroll
                    for (int bj = 0; bj < 2; ++bj) { const f32x4 a = acc[ai][bj][m][0], b = acc[ai][bj][m][1];
                        float s = (a[0] * a[0] + a[1] * a[1]) + (a[2] * a[2] + a[3] * a[3]) + (b[0] * b[0] + b[1] * b[1]) + (b[2] * b[2] + b[3] * b[3]);
                        s += __shfl_xor(s, 16); s += __shfl_xor(s, 32);
                        if (fq == 0) P[((ai * HALF + wr * 64 + m * 16 + fr) * 2 + bj) * 4 + wc] = s; }
            asm volatile("s_waitcnt lgkmcnt(0)" ::: "memory"); __builtin_amdgcn_s_barrier(); asm volatile("" ::: "memory");
            { const float* g = sect ? gk : gq;
              const f32x4 g0 = *(const f32x4*)(g + wc * 32 + 8 * fq), g1 = *(const f32x4*)(g + wc * 32 + 8 * fq + 4);
#pragma unroll
              for (int ai = 0; ai < 2; ++ai)
#pragma unroll
                for (int m = 0; m < 4; ++m) {
#pragma unroll
                    for (int bj = 0; bj < 2; ++bj) { const f32x4 pp = *(const PG8_LAS f32x4*)(P + ((ai * HALF + wr * 64 + m * 16 + fr) * 2 + bj) * 4);
                        const float rstd = __builtin_amdgcn_rsqf(((pp[0] + pp[1]) + (pp[2] + pp[3])) * (1.0f / 128.0f) + 1e-6f);
                        acc[ai][bj][m][0] = acc[ai][bj][m][0] * rstd * g0; acc[ai][bj][m][1] = acc[ai][bj][m][1] * rstd * g1; }
                    asm volatile("" ::: "memory"); } }
            if (wc == 0) {
                const bool lowhalf = fq < 2;
                typedef _Float16 h2_t __attribute__((ext_vector_type(2)));
#pragma unroll
                for (int ai = 0; ai < 2; ++ai)
#pragma unroll
                    for (int m = 0; m < 4; ++m) {
                        float cs[8], sn[8];
#pragma unroll
                        for (int w = 0; w < 4; ++w) { const unsigned own = tb[ai][m][w]; auto rr = __builtin_amdgcn_permlane32_swap(own, own, false, false); const unsigned oth = lowhalf ? rr[1] : rr[0];
                            const h2_t ho = __builtin_bit_cast(h2_t, own), hp = __builtin_bit_cast(h2_t, oth);
                            const float o0 = (float)ho[0], o1 = (float)ho[1], p0 = (float)hp[0], p1 = (float)hp[1];
                            cs[2 * w] = lowhalf ? o0 : p0; cs[2 * w + 1] = lowhalf ? o1 : p1; sn[2 * w] = lowhalf ? -p0 : o0; sn[2 * w + 1] = lowhalf ? -p1 : o1; }
#pragma unroll
                        for (int bj = 0; bj < 2; ++bj)
#pragma unroll
                            for (int i = 0; i < 4; ++i) {
                                { const float y = acc[ai][bj][m][0][i]; auto rr = __builtin_amdgcn_permlane32_swap(__builtin_bit_cast(unsigned, y), __builtin_bit_cast(unsigned, y), false, false);
                                  acc[ai][bj][m][0][i] = y * cs[i] + __builtin_bit_cast(float, lowhalf ? rr[1] : rr[0]) * sn[i]; }
                                { const float y = acc[ai][bj][m][1][i]; auto rr = __builtin_amdgcn_permlane32_swap(__builtin_bit_cast(unsigned, y), __builtin_bit_cast(unsigned, y), false, false);
                                  acc[ai][bj][m][1][i] = y * cs[4 + i] + __builtin_bit_cast(float, lowhalf ? rr[1] : rr[0]) * sn[4 + i]; }
                            }
                    }
            }
            if (sect == 1) {
                PG8_LAS float* KM = (PG8_LAS float*)(xs + 8192);
                float rv[16];
#pragma unroll
                for (int bj = 0; bj < 2; ++bj) { f32x4 c0 = acc[0][bj][0][0], c1 = acc[0][bj][0][1];
#pragma unroll
                    for (int ai = 0; ai < 2; ++ai)
#pragma unroll
                        for (int m = 0; m < 4; ++m) if (ai + m) { c0 += acc[ai][bj][m][0]; c1 += acc[ai][bj][m][1]; }
#pragma unroll
                    for (int i = 0; i < 4; ++i) { rv[bj * 8 + i] = c0[i]; rv[bj * 8 + 4 + i] = c1[i]; } }
#define TR_STEP(MM) { const bool up = (fr & (MM)) != 0; _Pragma("unroll") for (int i = 0; i < (MM); ++i) { const float send = up ? rv[i] : rv[i + (MM)], keep = up ? rv[i + (MM)] : rv[i]; rv[i] = keep + __shfl_xor(send, (MM)); } }
                TR_STEP(8) TR_STEP(4) TR_STEP(2) TR_STEP(1)
#undef TR_STEP
                KM[((wr * 4 + wc) * 4 + fq) * 16 + fr] = rv[0];
                asm volatile("s_waitcnt lgkmcnt(0)" ::: "memory"); __builtin_amdgcn_s_barrier(); asm volatile("" ::: "memory");
                const int tid = (wr * 4 + wc) * 64 + fq * 16 + fr;
                if (tid < 256) { const int bj = tid >> 7, d = tid & 127, w4 = d >> 5, q4 = (d >> 3) & 3, i = d & 7;
                    const float s = KM[((0 * 4 + w4) * 4 + q4) * 16 + bj * 8 + i] + KM[((1 * 4 + w4) * 4 + q4) * 16 + bj * 8 + i];
                    const int bb = u.pm >> 5, nb = u.pm & 31, head = (u.pn & 3) * 2 + bj;
                    kmean[((size_t)(bb * 8 + head) * 32 + nb) * 128 + d] = s * (1.0f / 256.0f); }
            }
        }
        const float osc = sect ? 1.f : qscale;
#pragma unroll
        for (int ai = 0; ai < 2; ++ai)
#pragma unroll
            for (int m = 0; m < 4; ++m)
#pragma unroll
                for (int bj = 0; bj < 2; ++bj) *(u32x4*)(base + off0 + (unsigned)((ai * HALF + m * 16) * 2048 + bj * 256)) = pack8(acc[ai][bj][m][0] * osc, acc[ai][bj][m][1] * osc);
    }
};
struct EpiC {
    static constexpr bool PERM = true, AFTER_DRAIN = false;
    const bf16_t* OA; bf16_t* AC; bf16_t* GA; const float* bias;
    __device__ __forceinline__ void operator()(const f32x4 (&acc)[2][2][4][2], const Unit& u, int wr, int wc, int fr, int fq) const {
        const int row0 = u.pm * BM + wr * 64 + fr;
        if (u.pn < 4) {
            const int col0 = u.pn * BM + wc * 32 + 8 * fq;
#pragma unroll
            for (int ai = 0; ai < 2; ++ai) {
                u32x4 ld[4][2];
#pragma unroll
                for (int m = 0; m < 4; ++m)
#pragma unroll
                    for (int bj = 0; bj < 2; ++bj) ld[m][bj] = __builtin_nontemporal_load((const u32x4*)(OA + (size_t)(row0 + ai * HALF + m * 16) * 1024 + col0 + bj * HALF));
#pragma unroll
                for (int m = 0; m < 4; ++m) { bf16_t* outp = AC + (size_t)(row0 + ai * HALF + m * 16) * 2048 + col0;
#pragma unroll
                    for (int bj = 0; bj < 2; ++bj) { f32x4 o0, o1; unpack8(ld[m][bj], o0, o1); const f32x4 z0 = acc[ai][bj][m][0], z1 = acc[ai][bj][m][1];
#pragma unroll
                        for (int i = 0; i < 4; ++i) { o0[i] *= silu(z0[i]); o1[i] *= silu(z1[i]); }
                        *(u32x4*)(outp + bj * HALF) = pack8(o0, o1); } }
                asm volatile("" ::: "memory"); }
        } else {
            const int col0 = (u.pn - 4) * BM + wc * 32 + 8 * fq;
            f32x4 bb[2][2];
#pragma unroll
            for (int bj = 0; bj < 2; ++bj) { bb[bj][0] = *(const f32x4*)(bias + col0 + bj * HALF); bb[bj][1] = *(const f32x4*)(bias + col0 + bj * HALF + 4); }
#pragma unroll
            for (int bj = 0; bj < 2; ++bj) { const f32x4 b0 = bb[bj][0], b1 = bb[bj][1];
#pragma unroll
                for (int ai = 0; ai < 2; ++ai)
#pragma unroll
                    for (int m = 0; m < 4; ++m) { bf16_t* rowp = GA + (size_t)(row0 + ai * HALF + m * 16) * 1024 + col0 + bj * HALF; f32x4 g0 = acc[ai][bj][m][0] + b0, g1 = acc[ai][bj][m][1] + b1;
#pragma unroll
                        for (int i = 0; i < 4; ++i) { g0[i] = sigm(g0[i]); g1[i] = sigm(g1[i]); }
                        *(u32x4*)rowp = pack8(g0, g1); } }
        }
    }
};
struct EpiA {
    static constexpr bool PERM = true, AFTER_DRAIN = false;
    bf16_t* GLU; bf16_t* SZC; bf16_t* GC; const float* bias;
    __device__ __forceinline__ void operator()(const f32x4 (&acc)[2][2][4][2], const Unit& u, int wr, int wc, int fr, int fq) const {
        const int row0 = u.pm * BM + wr * 64 + fr;
        if (u.pn < 8) {
            const int col0 = u.pn * HALF + wc * 32 + 8 * fq;
#pragma unroll
            for (int ai = 0; ai < 2; ++ai)
#pragma unroll
                for (int m = 0; m < 4; ++m) { bf16_t* rowp = GLU + (size_t)(row0 + ai * HALF + m * 16) * 1024 + col0; f32x4 a0 = acc[ai][0][m][0], a1 = acc[ai][0][m][1]; const f32x4 b0 = acc[ai][1][m][0], b1 = acc[ai][1][m][1];
#pragma unroll
                    for (int i = 0; i < 4; ++i) { a0[i] *= sigm(b0[i]); a1[i] *= sigm(b1[i]); }
                    *(u32x4*)rowp = pack8(a0, a1); }
        } else if (u.pn < 12) {
            const int col0 = (u.pn - 8) * BM + wc * 32 + 8 * fq;
#pragma unroll
            for (int ai = 0; ai < 2; ++ai)
#pragma unroll
                for (int m = 0; m < 4; ++m) { bf16_t* rowp = SZC + (size_t)(row0 + ai * HALF + m * 16) * 1024 + col0;
#pragma unroll
                    for (int bj = 0; bj < 2; ++bj) { f32x4 z0 = acc[ai][bj][m][0], z1 = acc[ai][bj][m][1];
#pragma unroll
                        for (int i = 0; i < 4; ++i) { z0[i] = silu(z0[i]); z1[i] = silu(z1[i]); }
                        *(u32x4*)(rowp + bj * HALF) = pack8(z0, z1); } }
        } else {
            const int col0 = (u.pn - 12) * BM + wc * 32 + 8 * fq;
            f32x4 bb[2][2];
#pragma unroll
            for (int bj = 0; bj < 2; ++bj) { bb[bj][0] = *(const f32x4*)(bias + col0 + bj * HALF); bb[bj][1] = *(const f32x4*)(bias + col0 + bj * HALF + 4); }
#pragma unroll
            for (int bj = 0; bj < 2; ++bj) { const f32x4 b0 = bb[bj][0], b1 = bb[bj][1];
#pragma unroll
                for (int ai = 0; ai < 2; ++ai)
#pragma unroll
                    for (int m = 0; m < 4; ++m) { bf16_t* rowp = GC + (size_t)(row0 + ai * HALF + m * 16) * 1024 + col0 + bj * HALF; f32x4 g0 = acc[ai][bj][m][0] + b0, g1 = acc[ai][bj][m][1] + b1;
#pragma unroll
                        for (int i = 0; i < 4; ++i) { g0[i] = sigm(g0[i]); g1[i] = sigm(g1[i]); }
                        *(u32x4*)rowp = pack8(g0, g1); } }
        }
    }
};
struct EpiCA {
    static constexpr bool PERM = true, AFTER_DRAIN = false;
    EpiC c; EpiA a; RowRstd rstd;
    const unsigned __attribute__((address_space(1)))* ddone; unsigned need;
    __device__ __forceinline__ void operator()(f32x4 (&acc)[2][2][4][2], const Unit& u, int wr, int wc, int fr, int fq) const {
        if (need && u.pn < 4) { while (__hip_atomic_load(ddone, __ATOMIC_RELAXED, __HIP_MEMORY_SCOPE_AGENT) < need) __builtin_amdgcn_s_sleep(1); asm volatile("" ::: "memory"); }
        rstd.ensure(u.pm, wr * 4 + wc, fq * 16 + fr);
        { int frx = fr; asm volatile("" : "+v"(frx));
          float rs[2][4];
#pragma unroll
          for (int ai = 0; ai < 2; ++ai)
#pragma unroll
            for (int m = 0; m < 4; ++m) rs[ai][m] = rstd.get(ai * HALF + wr * 64 + m * 16 + frx);
#pragma unroll
          for (int ai = 0; ai < 2; ++ai)
#pragma unroll
            for (int m = 0; m < 4; ++m)
#pragma unroll
                for (int bj = 0; bj < 2; ++bj) { acc[ai][bj][m][0] = acc[ai][bj][m][0] * rs[ai][m]; acc[ai][bj][m][1] = acc[ai][bj][m][1] * rs[ai][m]; } }
        if (u.pn < 8) c(acc, u, wr, wc, fr, fq); else { Unit v = u; v.pn = u.pn - 8; a(acc, v, wr, wc, fr, fq); }
    }
};
struct EpiM {
    static constexpr bool PERM = true, AFTER_DRAIN = false, MID = true;
    bf16_t* Mb; const bf16_t* GA; const bf16_t* GC;
    __device__ __forceinline__ void mid(f32x4 (&acc)[2][2][4][2], const Unit& u, int wr, int wc, int fr_in, int fq_in) const {
        int fr = fr_in, fq = fq_in; asm volatile("" : "+v"(fr), "+v"(fq));
        const int row0 = u.pm * BM + wr * 64 + fr, col0 = u.pn * BM + wc * 32 + 8 * fq;
#pragma unroll
        for (int ai = 0; ai < 2; ++ai)
#pragma unroll
            for (int mh = 0; mh < 2; ++mh) {
                u32x4 la[2][2], lc[2][2];
#pragma unroll
                for (int m2 = 0; m2 < 2; ++m2)
#pragma unroll
                    for (int bj = 0; bj < 2; ++bj) { const unsigned off = (unsigned)((row0 + ai * HALF + (mh * 2 + m2) * 16) * 1024 + col0 + bj * HALF); la[m2][bj] = *(const u32x4*)(GA + off); lc[m2][bj] = *(const u32x4*)(GC + off); }
#pragma unroll
                for (int m2 = 0; m2 < 2; ++m2)
#pragma unroll
                    for (int bj = 0; bj < 2; ++bj) { const int m = mh * 2 + m2; f32x4 a0, a1, c0, c1; unpack8(la[m2][bj], a0, a1); unpack8(lc[m2][bj], c0, c1);
#pragma unroll
                        for (int i = 0; i < 4; ++i) { acc[ai][bj][m][0][i] *= a0[i] * __builtin_amdgcn_rcpf(c0[i]); acc[ai][bj][m][1][i] *= a1[i] * __builtin_amdgcn_rcpf(c1[i]); } }
                asm volatile("" ::: "memory"); }
    }
    __device__ __forceinline__ void operator()(const f32x4 (&acc)[2][2][4][2], const Unit& u, int wr, int wc, int fr_in, int fq_in) const {
        int fr = fr_in, fq = fq_in; asm volatile("" : "+v"(fr), "+v"(fq));
        const int row0 = u.pm * BM + wr * 64 + fr, col0 = u.pn * BM + wc * 32 + 8 * fq;
#pragma unroll
        for (int ai = 0; ai < 2; ++ai) {
            u32x4 lc[4][2];
#pragma unroll
            for (int m = 0; m < 4; ++m)
#pragma unroll
                for (int bj = 0; bj < 2; ++bj) lc[m][bj] = *(const u32x4*)(GC + (unsigned)((row0 + ai * HALF + m * 16) * 1024 + col0 + bj * HALF));
#pragma unroll
            for (int m = 0; m < 4; ++m)
#pragma unroll
                for (int bj = 0; bj < 2; ++bj) { f32x4 c0, c1; unpack8(lc[m][bj], c0, c1);
                    *(u32x4*)(Mb + (unsigned)((row0 + ai * HALF + m * 16) * 1024 + col0 + bj * HALF)) = pack8(c0 * acc[ai][bj][m][0], c1 * acc[ai][bj][m][1]); }
            asm volatile("" ::: "memory"); }
    }
};
struct EpiOut {
    static constexpr bool PERM = false, AFTER_DRAIN = false;
    const float* xres; float* out; bf16_t* xn; const float* gnext; float* ss;
    __device__ __forceinline__ void operator()(const f32x4 (&acc)[2][2][4][2], const Unit& u, int wr, int wc, int fr_in, int fq_in) const {
        int fr = fr_in, fq = fq_in; asm volatile("" : "+v"(fr), "+v"(fq));
        const int row0 = u.pm * BM + wr * 64 + fr, col0 = u.pn * BM + wc * 32 + 4 * fq;
        f32x4 gv[2][2];
        if (xn) {
#pragma unroll
            for (int bj = 0; bj < 2; ++bj)
#pragma unroll
                for (int n = 0; n < 2; ++n) gv[bj][n] = *(const f32x4*)(gnext + col0 + bj * HALF + n * 16); }
#pragma unroll
        for (int ai = 0; ai < 2; ++ai) {
            f32x4 xr[4][2][2];
#pragma unroll
            for (int m = 0; m < 4; ++m)
#pragma unroll
                for (int bj = 0; bj < 2; ++bj)
#pragma unroll
                    for (int n = 0; n < 2; ++n) xr[m][bj][n] = *(const f32x4*)(xres + (unsigned)((row0 + ai * HALF + m * 16) * 1024 + col0) + bj * HALF + n * 16);
#pragma unroll
            for (int m = 0; m < 4; ++m) { const unsigned off = (unsigned)((row0 + ai * HALF + m * 16) * 1024 + col0); float s = 0.f;
#pragma unroll
                for (int bj = 0; bj < 2; ++bj)
#pragma unroll
                    for (int n = 0; n < 2; ++n) { const f32x4 o = xr[m][bj][n] + acc[ai][bj][m][n]; *(f32x4*)(out + off + bj * HALF + n * 16) = o;
                        if (xn) { s += (o[0] * o[0] + o[1] * o[1]) + (o[2] * o[2] + o[3] * o[3]); const f32x4 y = o * gv[bj][n];
                            *(unsigned long long*)(xn + off + bj * HALF + n * 16) = (unsigned long long)cvt_pk_bf16(y[0], y[1]) | ((unsigned long long)cvt_pk_bf16(y[2], y[3]) << 32); } }
                if (xn) { s += __shfl_xor(s, 16); s += __shfl_xor(s, 32); if (fq == 0) ss[(unsigned)((row0 + ai * HALF + m * 16) * 16 + u.pn * 4 + wc)] = s; } }
            asm volatile("" ::: "memory"); }
    }
};

template <class T, class = void> struct epi_has_mid { static constexpr bool value = false; };
template <class T> struct epi_has_mid<T, decltype((void)T::MID)> { static constexpr bool value = T::MID; };
template <class Epi, class Sched, bool ALIGN_EPI = false, bool SP2 = false>
__device__ __forceinline__ void gemm_phase(PG8_LAS unsigned char* lds, const Gemm g, const Sched& S, const Epi& E) {
    int tid_ = threadIdx.x; asm volatile("" : "+v"(tid_));
    const int tid = tid_, wid = __builtin_amdgcn_readfirstlane(tid >> 6), lane = tid & 63, wr = wid >> 2, wc = wid & 3, fr = lane & 15, fq = lane >> 4;
    const int K = g.K, nt = K / BK;
    unsigned voffA[2], voffB[2];
#pragma unroll
    for (int i = 0; i < 2; ++i) { int R, C; stage_rc(tid * 16 + i * 8192, R, C); const int Rb = Epi::PERM ? ((R & ~31) + perm32(R & 31)) : R;
        voffA[i] = (unsigned)(R * K + C) * 2u; voffB[i] = (unsigned)(Rb * K + C) * 2u; }
    const size_t kstep = (size_t)(BK * 2);
    const size_t hstep = (size_t)HALF * K * 2;
    const size_t tstep = 2 * hstep;
    const unsigned ldsw = (unsigned)wid * 1024u;
    const int aoff = lds_byte(wr * 64 + fr, fq * 8), boff = lds_byte(wc * 32 + fr, fq * 8);
#define PG8_SA(b, h) (((b) * 2 + (h)) * HTB)
#define PG8_SB(b, h) ((4 + (b) * 2 + (h)) * HTB)
#define PG8_STAGE(bufoff, gbase, voff) do { _Pragma("unroll") for (int _i = 0; _i < 2; ++_i) \
        __builtin_amdgcn_global_load_lds((const unsigned*)((const char*)(gbase) + (voff)[_i]), (PG8_LAS unsigned*)(lds + (bufoff) + ldsw + _i * 8192), 16, 0, 0); } while (0)
#define PG8_LDA(dst, b, h) do { _Pragma("unroll") for (int m = 0; m < 4; ++m) _Pragma("unroll") for (int k = 0; k < 2; ++k) dst[m][k] = *(const PG8_LAS bf16x8*)(lds + PG8_SA(b, h) + aoff + m * 2048 + k * 1024); } while (0)
#define PG8_LDB(dst, b, h) do { _Pragma("unroll") for (int n = 0; n < 2; ++n) _Pragma("unroll") for (int k = 0; k < 2; ++k) dst[n][k] = *(const PG8_LAS bf16x8*)(lds + PG8_SB(b, h) + boff + n * 2048 + k * 1024); } while (0)
#define PG8_MMA(ai, bj, At, Bt) do { __builtin_amdgcn_s_setprio(1); _Pragma("unroll") for (int m = 0; m < 4; ++m) _Pragma("unroll") for (int n = 0; n < 2; ++n) _Pragma("unroll") for (int k = 0; k < 2; ++k) \
        acc[ai][bj][m][n] = __builtin_amdgcn_mfma_f32_16x16x32_bf16(Bt[n][k], At[m][k], acc[ai][bj][m][n], 0, 0, 0); __builtin_amdgcn_s_setprio(0); } while (0)
#define PG8_WAIT_V(n) asm volatile("s_waitcnt vmcnt(" #n ")" ::: "memory")
#define PG8_WAIT_L(n) asm volatile("s_waitcnt lgkmcnt(" #n ")" ::: "memory")
#define PG8_BAR __builtin_amdgcn_s_barrier()
#define PG8_SCHED __builtin_amdgcn_sched_barrier(0)
    Unit cur, nxt; int ui = 0;
    if (!S.next(0, cur)) return;
    f32x4 acc[2][2][4][2];
#pragma unroll
    for (int a = 0; a < 2; ++a)
#pragma unroll
        for (int b = 0; b < 2; ++b)
#pragma unroll
            for (int m = 0; m < 4; ++m)
#pragma unroll
                for (int n = 0; n < 2; ++n) acc[a][b][m][n] = (f32x4){0.f, 0.f, 0.f, 0.f};
    bf16x8 At[4][2], B0[2][2], B1[2][2];
    const char* cA = (const char*)g.A + (size_t)cur.pm * tstep; const char* cB = (const char*)g.Bt + (size_t)cur.pn * tstep;
    S.a_ready(cur);
    if constexpr (SP2) {
        PG8_STAGE(PG8_SB(0, 0), cB, voffB); PG8_STAGE(PG8_SB(0, 1), cB + hstep, voffB); PG8_STAGE(PG8_SA(0, 0), cA, voffA); PG8_STAGE(PG8_SA(0, 1), cA + hstep, voffA);
        if (wr == 1) PG8_BAR;
        PG8_WAIT_V(2); PG8_BAR;
        PG8_STAGE(PG8_SB(1, 0), cB + kstep, voffB); PG8_STAGE(PG8_SA(1, 0), cA + kstep, voffA); PG8_STAGE(PG8_SB(1, 1), cB + hstep + kstep, voffB);
        PG8_WAIT_V(6); PG8_BAR;
    } else {
        PG8_STAGE(PG8_SB(0, 0), cB, voffB); PG8_STAGE(PG8_SA(0, 0), cA, voffA); PG8_STAGE(PG8_SB(0, 1), cB + hstep, voffB); PG8_STAGE(PG8_SA(0, 1), cA + hstep, voffA);
        if (wr == 1) PG8_BAR;
        PG8_WAIT_V(4); PG8_BAR;
        PG8_STAGE(PG8_SB(1, 0), cB + kstep, voffB); PG8_STAGE(PG8_SA(1, 0), cA + kstep, voffA); PG8_STAGE(PG8_SB(1, 1), cB + hstep + kstep, voffB);
        PG8_WAIT_V(6); PG8_BAR;
    }
    for (;;) {
        const bool has_next = S.next(ui + 1, nxt);
        const char* nA = has_next ? (const char*)g.A + (size_t)nxt.pm * tstep : cA; const char* nB = has_next ? (const char*)g.Bt + (size_t)nxt.pn * tstep : cB;
        for (int t = 0; t < nt; t += 2) {
            if constexpr (epi_has_mid<Epi>::value) { if (t == nt / 2) E.mid(acc, cur, wr, wc, fr, fq); }
            const bool last = (t == nt - 2);
            const char* a1 = cA + (size_t)(t + 1) * kstep;
            const char* a2 = last ? nA : cA + (size_t)(t + 2) * kstep; const char* b2 = last ? nB : cB + (size_t)(t + 2) * kstep;
            const char* a3 = a2 + kstep; const char* b3 = b2 + kstep;
            if (last && has_next) S.a_ready(nxt);
            if constexpr (SP2) {
            PG8_LDB(B0, 0, 0); PG8_LDB(B1, 0, 1); PG8_SCHED; PG8_LDA(At, 0, 0); PG8_STAGE(PG8_SA(1, 1), a1 + hstep, voffA);
            PG8_WAIT_V(8); PG8_WAIT_L(0); PG8_BAR; PG8_MMA(0, 0, At, B0); PG8_MMA(0, 1, At, B1); PG8_BAR; PG8_SCHED;
            PG8_LDA(At, 0, 1); PG8_STAGE(PG8_SB(0, 0), b2, voffB); PG8_STAGE(PG8_SB(0, 1), b2 + hstep, voffB); PG8_STAGE(PG8_SA(0, 0), a2, voffA);
            PG8_WAIT_V(8); PG8_WAIT_L(0); PG8_BAR; PG8_MMA(1, 0, At, B0); PG8_MMA(1, 1, At, B1); PG8_BAR; PG8_SCHED;
            PG8_LDB(B0, 1, 0); PG8_LDB(B1, 1, 1); PG8_SCHED; PG8_LDA(At, 1, 0); PG8_STAGE(PG8_SA(0, 1), a2 + hstep, voffA);
            PG8_WAIT_V(8); PG8_WAIT_L(0); PG8_BAR; PG8_MMA(0, 0, At, B0); PG8_MMA(0, 1, At, B1); PG8_BAR; PG8_SCHED;
            PG8_LDA(At, 1, 1); PG8_STAGE(PG8_SB(1, 0), b3, voffB); PG8_STAGE(PG8_SB(1, 1), b3 + hstep, voffB); PG8_STAGE(PG8_SA(1, 0), a3, voffA);
            PG8_WAIT_V(8); PG8_WAIT_L(0); PG8_BAR; PG8_MMA(1, 0, At, B0); PG8_MMA(1, 1, At, B1); PG8_BAR; PG8_SCHED;
            } else {
            PG8_LDB(B0, 0, 0); PG8_SCHED; PG8_LDA(At, 0, 0); PG8_STAGE(PG8_SA(1, 1), a1 + hstep, voffA);
            PG8_WAIT_L(8); PG8_BAR; PG8_WAIT_L(0); PG8_MMA(0, 0, At, B0); PG8_BAR; PG8_SCHED;
            PG8_LDB(B1, 0, 1); PG8_STAGE(PG8_SB(0, 0), b2, voffB);
            PG8_BAR; PG8_WAIT_L(0); PG8_MMA(0, 1, At, B1); PG8_BAR;
            PG8_LDA(At, 0, 1); PG8_STAGE(PG8_SA(0, 0), a2, voffA);
            PG8_BAR; PG8_WAIT_L(0); PG8_MMA(1, 0, At, B0); PG8_BAR; PG8_SCHED;
            PG8_STAGE(PG8_SB(0, 1), b2 + hstep, voffB);
            PG8_WAIT_V(6); PG8_BAR; PG8_MMA(1, 1, At, B1); PG8_BAR;
            PG8_LDB(B0, 1, 0); PG8_SCHED; PG8_LDA(At, 1, 0); PG8_STAGE(PG8_SA(0, 1), a2 + hstep, voffA);
            PG8_WAIT_L(8); PG8_BAR; PG8_WAIT_L(0); PG8_MMA(0, 0, At, B0); PG8_BAR; PG8_SCHED;
            PG8_LDB(B1, 1, 1); PG8_STAGE(PG8_SB(1, 0), b3, voffB);
            PG8_BAR; PG8_WAIT_L(0); PG8_MMA(0, 1, At, B1); PG8_BAR;
            PG8_LDA(At, 1, 1); PG8_STAGE(PG8_SA(1, 0), a3, voffA);
            PG8_BAR; PG8_WAIT_L(0); PG8_MMA(1, 0, At, B0); PG8_BAR; PG8_SCHED;
            PG8_STAGE(PG8_SB(1, 1), b3 + hstep, voffB);
            PG8_WAIT_V(6); PG8_BAR; PG8_MMA(1, 1, At, B1); PG8_BAR;
            }
        }
        if constexpr (ALIGN_EPI) { if (wr == 0) PG8_BAR; }
#if defined(PROBE_PHASE) && (PROBE_PHASE == 400 || PROBE_PHASE == 401)
        { __builtin_amdgcn_sched_barrier(0); const unsigned long long t0_ = __builtin_amdgcn_s_memrealtime(); __builtin_amdgcn_sched_barrier(0);
          if constexpr (!Epi::AFTER_DRAIN) { E(acc, cur, wr, wc, fr, fq); S.done(cur); }
          if (PROBE_PHASE == 400) asm volatile("s_waitcnt vmcnt(0)" ::: "memory"); __builtin_amdgcn_sched_barrier(0); const unsigned long long t1_ = __builtin_amdgcn_s_memrealtime();
          if (lane == 0 && wid == 0) *(volatile PG8_LAS unsigned*)(lds + 131072 + 320 + 64) += (unsigned)(t1_ - t0_); }
#else
        if constexpr (!Epi::AFTER_DRAIN) { E(acc, cur, wr, wc, fr, fq); S.done(cur); }
#endif
        if (!has_next) break;
#pragma unroll
        for (int a = 0; a < 2; ++a)
#pragma unroll
            for (int b = 0; b < 2; ++b)
#pragma unroll
                for (int m = 0; m < 4; ++m)
#pragma unroll
                    for (int n = 0; n < 2; ++n) acc[a][b][m][n] = (f32x4){0.f, 0.f, 0.f, 0.f};
        cur = nxt; cA = nA; cB = nB; ++ui;
        if constexpr (ALIGN_EPI) { if (wr == 1) PG8_BAR; }
    }
    PG8_WAIT_V(0);
    if constexpr (!ALIGN_EPI) { if (wr == 0) PG8_BAR; }
    PG8_BAR;
    if constexpr (Epi::AFTER_DRAIN) { E.fused(acc, cur, wr, wc, fr, fq, lds, wid, lane); S.done(cur); }
#undef PG8_SA
#undef PG8_SB
#undef PG8_STAGE
#undef PG8_LDA
#undef PG8_LDB
#undef PG8_MMA
#undef PG8_WAIT_V
#undef PG8_WAIT_L
#undef PG8_BAR
#undef PG8_SCHED
}
}

#ifndef PG8_SP2
#define PG8_SP2 true
#endif
#ifndef PG8_ALIGN
#define PG8_ALIGN true
#endif
#ifndef MK_PER_PHASE
#define MK_PER_PHASE 0
#endif

constexpr int NWAVES = 8;
constexpr int BATCH = 2, SEQ = 8192, DM = 1024, DEPTH = 2, NH = 8, HD = 128, NBLK = 32, MOBA = 256, CK = 31;
constexpr int M = BATCH * SEQ;
constexpr int N_IN = 9216;
constexpr float EPS = 1e-6f;
constexpr float QSCALE = 0.08838834764831845f * 1.4426950408889634f;
constexpr int NPHASE_L = 10, NPHASES = NPHASE_L * DEPTH;

constexpr size_t MiB = 1u << 20;
constexpr size_t WS_CTL = 0, CTL_ZERO_BYTES = 65536;
constexpr size_t WS_ROPE = 1 * MiB;
constexpr size_t WS_KMEAN = 2 * MiB;
constexpr size_t WS_LPART = 2 * MiB + 512 * 1024;
constexpr size_t WS_WT = 4 * MiB;
constexpr size_t WT_B = 0, WT_C = 3072, WT_A = 5120, WT_PA = 9216, WT_PC = 10240, WT_O = 11264, WT_ROWS = 12288;
constexpr size_t WS_XN = 28 * MiB;
constexpr size_t WS_Q = 60 * MiB, WS_K = 92 * MiB, WS_V = 124 * MiB;
constexpr size_t WS_LIST = 156 * MiB;
constexpr size_t WS_PART = 172 * MiB;
constexpr size_t WS_GA = 92 * MiB, WS_GLU = 124 * MiB, WS_SZC = 156 * MiB, WS_GC = 188 * MiB, WS_AC = 220 * MiB  , WS_SS = 284 * MiB  , WS_WO1 = 285 * MiB  , WS_END = 287 * MiB;
constexpr size_t WS_MB = WS_Q;
constexpr int CW_BAR = 1024;
constexpr int CW_CNT = 8192;
constexpr int CW_DDONE = 9472;
static_assert((CW_DDONE + DEPTH * 64) * 4 <= (int)CTL_ZERO_BYTES && CW_CNT + DEPTH * 512 <= CW_DDONE && CW_BAR + 3456 <= CW_CNT, "CTL map");

constexpr int RING_OFF = 0, RING_BYTES = 131072;
constexpr int LDSCTL_OFF = RING_BYTES, MISC_OFF = LDSCTL_OFF + 320;
constexpr int XTRA_OFF = RING_BYTES + 512;
constexpr int STG_OFF = XTRA_OFF + 8192;
constexpr int LDS_BYTES = 163840;
constexpr int RSTD_OFF = STG_OFF + 2048;
constexpr int RTAB_OFF = RSTD_OFF + 16384;
static_assert(RTAB_OFF + 1024 <= LDS_BYTES, "LDS map");
static_assert(STG_OFF + 8 * 2176 <= LDS_BYTES, "LDS map");
#define GAS __attribute__((address_space(1)))
#define LAS __attribute__((address_space(3)))
typedef unsigned short bf16;
typedef unsigned v4u __attribute__((ext_vector_type(4)));
typedef float f32x4 __attribute__((ext_vector_type(4)));
typedef short bf16x8 __attribute__((ext_vector_type(8)));
typedef GAS unsigned gu32;
typedef GAS unsigned long long gu64;
#define RLX_AGENT __ATOMIC_RELAXED, __HIP_MEMORY_SCOPE_AGENT
#define LDS_WAIT() asm volatile("s_waitcnt lgkmcnt(0)" ::: "memory")
#define VM_WAIT() asm volatile("s_waitcnt vmcnt(0)" ::: "memory")
__device__ __forceinline__ unsigned long long rt() { return __builtin_amdgcn_s_memrealtime(); }
__device__ __forceinline__ unsigned f2bf(float f) { unsigned u = __builtin_bit_cast(unsigned, f); return (u + 0x7fffu + ((u >> 16) & 1u)) >> 16; }
__device__ __forceinline__ unsigned pk2(float lo, float hi) { return f2bf(lo) | (f2bf(hi) << 16); }

#define XB_TMO      128
#define XB_XCNT(j)  (256  + 64 * (j))
#define XB_XSUB(j)  (1280 + 64 * (j))
#define XB_XGEN(j)  (2304 + 64 * (j))
#define XB_TOP      3328
#define XB_TOPGEN   3392
#define XCD_BAR_WORDS 3456
#define XB_SPIN_CAP (1u << 18)

__device__ __forceinline__ unsigned xb_ld(unsigned* p)              { return __hip_atomic_load(p, __ATOMIC_RELAXED, __HIP_MEMORY_SCOPE_AGENT); }
__device__ __forceinline__ unsigned xb_add(unsigned* p, unsigned v) { return __hip_atomic_fetch_add(p, v, __ATOMIC_RELAXED, __HIP_MEMORY_SCOPE_AGENT); }
__device__ __forceinline__ unsigned xb_xcc_id() { return (unsigned)__builtin_amdgcn_s_getreg((3 << 11) | 20) & 0xFu; }
#define XB_SPIN(cond, bar) do { unsigned _sp = 0; while (cond) { __builtin_amdgcn_s_sleep(1); \
    if ((++_sp & 255u) == 0u) { if (xb_ld(&(bar)[XB_TMO])) break; if (_sp > XB_SPIN_CAP) { atomicAdd(&(bar)[XB_TMO], 1u); break; } } } } while (0)

struct XcdBarrier {
    unsigned* bar; unsigned x;
    volatile LAS unsigned* st;
};

__device__ __forceinline__ XcdBarrier xcd_barrier_post(unsigned* bar, volatile LAS unsigned* st) {
    XcdBarrier b; b.bar = bar; b.x = xb_xcc_id(); b.st = st;
    if (threadIdx.x == 0) (void)xb_add(&bar[XB_XCNT(b.x)], 1u);
    return b;
}
__device__ __forceinline__ void xcd_barrier_complete(unsigned* bar, unsigned x, unsigned& nloc, unsigned& nx) {
    const unsigned G = gridDim.x * gridDim.y * gridDim.z;
    unsigned sum, cnt, mine, sp = 0u;
    for (;;) {
        sum = 0u; cnt = 0u; mine = 0u;
#pragma unroll
        for (unsigned j = 0; j < 16; ++j) { const unsigned c = xb_ld(&bar[XB_XCNT(j)]); sum += c; cnt += (c > 0u) ? 1u : 0u; mine = (j == x) ? c : mine; }
        if (sum == G) break;
        __builtin_amdgcn_s_sleep(1);
        if ((++sp & 255u) == 0u) { if (xb_ld(&bar[XB_TMO])) break; if (sp > XB_SPIN_CAP) { atomicAdd(&bar[XB_TMO], 1u); break; } }
    }
    nloc = mine > 0u ? mine : 1u; nx = cnt > 0u ? cnt : 1u;
}

__device__ __forceinline__ void xcd_barrier(const XcdBarrier& b) {
    asm volatile("s_waitcnt vmcnt(0)" ::: "memory");
    __syncthreads();
    if (threadIdx.x == 0) {
        GAS unsigned* bar_g = (GAS unsigned*)b.bar; unsigned bx_ = b.x;
        asm volatile("" : "+s"(bar_g), "+s"(bx_)); unsigned* bar = (unsigned*)bar_g;
        __builtin_amdgcn_s_waitcnt(0);
        unsigned nloc = b.st[0], nx = b.st[1];
        if (nloc == 0u) { xcd_barrier_complete(bar, bx_, nloc, nx); b.st[0] = nloc; b.st[1] = nx; }
        const unsigned old = xb_add(&bar[XB_XSUB(bx_)], 1u);
        const unsigned gen = old / nloc;
        if (old + 1u == (gen + 1u) * nloc) {
            __builtin_amdgcn_fence(__ATOMIC_RELEASE, "agent");
            asm volatile("s_waitcnt vmcnt(0)" ::: "memory");
            const unsigned og = xb_add(&bar[XB_TOP], 1u);
            const unsigned tg = og / nx;
            if (og + 1u == (tg + 1u) * nx) xb_add(&bar[XB_TOPGEN], 1u);
            else XB_SPIN(xb_ld(&bar[XB_TOPGEN]) == tg, bar);
            __builtin_amdgcn_fence(__ATOMIC_ACQUIRE, "agent");
            xb_add(&bar[XB_XGEN(bx_)], 1u);
            asm volatile("s_waitcnt vmcnt(0)" ::: "memory");
        } else {
            XB_SPIN(xb_ld(&bar[XB_XGEN(bx_)]) == gen, bar);
            __builtin_amdgcn_fence(__ATOMIC_ACQUIRE, "agent");
            asm volatile("s_waitcnt vmcnt(0)" ::: "memory");
        }
    }
    __syncthreads();
}

typedef float f32x16 __attribute__((ext_vector_type(16)));
typedef short v4i16_t __attribute__((ext_vector_type(4)));
typedef float f32x2v __attribute__((ext_vector_type(2)));
struct Frame {
    LAS unsigned char* lds;
    volatile LAS unsigned* MISC;
    gu32* ctl;
    int tid, lane, wave;
    int vcu, G;
    unsigned char* ws;
    unsigned long long pacc, pt0;
};
#ifndef PROBE_PHASE
#define PROBE_PHASE -1
#endif
#define PSUB_BEGIN(code) do { if (PROBE_PHASE == (code)) { __builtin_amdgcn_sched_barrier(0); F.pt0 = rt(); __builtin_amdgcn_sched_barrier(0); } } while (0)
#define PSUB_END(code) do { if (PROBE_PHASE == (code)) { __builtin_amdgcn_sched_barrier(0); F.pacc += rt() - F.pt0; __builtin_amdgcn_sched_barrier(0); } } while (0)
struct Args { const float* in[13]; float* out; unsigned char* ws; int ph_lo, ph_hi; };
#define KARG ((const volatile __attribute__((address_space(4))) Args*)__builtin_amdgcn_kernarg_segment_ptr())
#define ARG_IN(i) ((const float*)KARG->in[i])
#define ARG_OUT ((float*)KARG->out)
__device__ __forceinline__ float wave_sum(float v) {
#pragma unroll
    for (int o = 1; o < 64; o <<= 1) v += __shfl_xor(v, o);
    return v;
}
__device__ __forceinline__ float wave_max(float v) {
#pragma unroll
    for (int o = 1; o < 64; o <<= 1) v = fmaxf(v, __shfl_xor(v, o));
    return v;
}
using pg8::cvt_pk_bf16; using pg8::bf_lo; using pg8::bf_hi; using pg8::sigm; using pg8::silu;

__device__ __forceinline__ void p0_transpose_item(const float* W, int ldw, int src_col0, bf16* WT, int dst_row0, int dpitch, int dk0, int k0, LAS float* scr, int lane) {
    f32x4 wv[8];
    const float* src = W + (size_t)(k0 + (lane >> 3)) * ldw + src_col0 + 4 * (lane & 7);
#pragma unroll
    for (int i = 0; i < 8; ++i) wv[i] = __builtin_nontemporal_load((const GAS f32x4*)(src + (size_t)(8 * i) * ldw));
#pragma unroll
    for (int i = 0; i < 8; ++i) { const int kk = 8 * i + (lane >> 3), n0 = 4 * (lane & 7); *(LAS f32x4*)(scr + kk * 36 + (n0 ^ (8 * ((kk >> 4) & 3)))) = wv[i]; }
    LDS_WAIT(); asm volatile("" ::: "memory");
    const int c = lane & 7;
#pragma unroll
    for (int j = 0; j < 4; ++j) { const int n = (lane >> 3) + 8 * j; float t[8];
#pragma unroll
        for (int q = 0; q < 8; ++q) { const int kk = 8 * c + q; t[q] = scr[kk * 36 + (n ^ (8 * ((c >> 1) & 3)))]; }
        v4u o; o.x = pk2(t[0], t[1]); o.y = pk2(t[2], t[3]); o.z = pk2(t[4], t[5]); o.w = pk2(t[6], t[7]);
        *(GAS v4u*)(WT + (size_t)(dst_row0 + n) * dpitch + dk0 + k0 + 8 * c) = o; }
    LDS_WAIT(); asm volatile("" ::: "memory");
}
__device__ __forceinline__ void ph0_prologue(Frame& F, int l, const float* xin) {
    LAS float* scr = (LAS float*)(F.lds + RING_OFF + F.wave * 16384);
    const int gw = F.vcu * NWAVES + F.wave, NGW = F.G * NWAVES;
    bf16* WT = (bf16*)(F.ws + WS_WT);
    const float* w_in = ARG_IN(2) + (size_t)l * DM * N_IN;
    const float* w_pa = ARG_IN(10) + (size_t)l * DM * DM; const float* w_pc = ARG_IN(11) + (size_t)l * DM * DM; const float* w_o = ARG_IN(12) + (size_t)l * DM * DM;
    PSUB_BEGIN(300);
    constexpr int NRB = WT_ROWS / 32, NITEMS = NRB * (DM / 64);
    for (int it = gw; it < NITEMS; it += NGW) {
        const int rb = it % NRB, kb = it / NRB, r = rb * 32;
        const float* W; int ldw, src, drow = r, dpitch = DM, dk0 = 0;
        if (r < (int)WT_C) { W = w_in; ldw = N_IN; src = r; }
        else if (r < (int)WT_A) { const int q = r - (int)WT_C; W = w_in; ldw = N_IN; src = q < 1024 ? 3072 + q : 7168 + (q - 1024); }
        else if (r < (int)WT_PA) { const int q = r - (int)WT_A; W = w_in; ldw = N_IN;
            if (q < 2048) { const int pn = q >> 8, bj = (q >> 7) & 1, i = q & 127; src = 4096 + 1024 * bj + 128 * pn + i; }
            else if (q < 3072) src = 6144 + (q - 2048);
            else src = 8192 + (q - 3072); }
        else if (r < (int)WT_O) {
            const int q = r - (int)WT_PA, half = q >> 10; W = half ? w_pc : w_pa; ldw = DM; src = q & 1023;
            WT = (bf16*)(F.ws + WS_WT) + WT_PA * DM; drow = q & 1023; dpitch = 2 * DM; dk0 = half * DM; }
        else { W = w_o; ldw = DM; src = r - (int)WT_O; if (l == 1) { WT = (bf16*)(F.ws + WS_WO1); drow = r - (int)WT_O; } }
        p0_transpose_item(W, ldw, src, WT, drow, dpitch, dk0, kb * 64, scr, F.lane);
        WT = (bf16*)(F.ws + WS_WT);
    }
    PSUB_END(300); PSUB_BEGIN(301);
    if (l == 0) {
        const float* g = ARG_IN(1); bf16* XN = (bf16*)(F.ws + WS_XN); float* SS = (float*)(F.ws + WS_SS);
        f32x4 gv[4];
#pragma unroll
        for (int j = 0; j < 4; ++j) gv[j] = ((const GAS f32x4*)g)[F.lane + 64 * j];
        for (int m = gw; m < M; m += 2 * NGW) {
            const int m2 = m + NGW;
            const GAS f32x4* xr = (const GAS f32x4*)(xin + (size_t)m * DM) + F.lane; const GAS f32x4* xr2 = (const GAS f32x4*)(xin + (size_t)m2 * DM) + F.lane;
            f32x4 v[4], v2[4]; float s = 0.f, s2 = 0.f;
#pragma unroll
            for (int j = 0; j < 4; ++j) { v[j] = xr[64 * j]; v2[j] = xr2[64 * j]; }
#pragma unroll
            for (int j = 0; j < 4; ++j) { s += (v[j].x * v[j].x + v[j].y * v[j].y) + (v[j].z * v[j].z + v[j].w * v[j].w); s2 += (v2[j].x * v2[j].x + v2[j].y * v2[j].y) + (v2[j].z * v2[j].z + v2[j].w * v2[j].w); }
            s = wave_sum(s); s2 = wave_sum(s2);
            if (F.lane < 16) { SS[(size_t)m * 16 + F.lane] = F.lane == 0 ? s : 0.f; SS[(size_t)m2 * 16 + F.lane] = F.lane == 0 ? s2 : 0.f; }
            GAS unsigned long long* o8 = (GAS unsigned long long*)(XN + (size_t)m * DM) + F.lane; GAS unsigned long long* o82 = (GAS unsigned long long*)(XN + (size_t)m2 * DM) + F.lane;
#pragma unroll
            for (int j = 0; j < 4; ++j) { const f32x4 y = v[j] * gv[j]; o8[64 * j] = (unsigned long long)cvt_pk_bf16(y.x, y.y) | ((unsigned long long)cvt_pk_bf16(y.z, y.w) << 32);
                const f32x4 y2 = v2[j] * gv[j]; o82[64 * j] = (unsigned long long)cvt_pk_bf16(y2.x, y2.y) | ((unsigned long long)cvt_pk_bf16(y2.z, y2.w) << 32); }
        }
    }
    PSUB_END(301);
    if (blockIdx.x == 0) { gu32* cnt = F.ctl + CW_CNT + l * 512; cnt[F.tid] = 0u; }
    if (l == 0) {
        _Float16* rt16 = (_Float16*)(F.ws + WS_ROPE);
        constexpr float IF[16] = {1.000000000e+00f, 4.403665960e-01f, 1.939227432e-01f, 8.539710194e-02f, 3.760603070e-02f, 1.656044088e-02f, 7.292664610e-03f, 3.211446106e-03f,
                                  1.414213562e-03f, 6.227724371e-04f, 2.742481884e-04f, 1.207697351e-04f, 5.318295734e-05f, 2.341999971e-05f, 1.031338525e-05f, 4.541670478e-06f};
        const int fi = F.lane & 15; float invf = IF[0];
#pragma unroll
        for (int i = 1; i < 16; ++i) invf = (fi == i) ? IF[i] : invf;
        for (int gt = (F.vcu * NWAVES + F.wave) * 64 + F.lane; gt < SEQ * 16; gt += NGW * 64) {
            const int t = gt >> 4; float sn, cs; sincosf((float)t * invf, &sn, &cs); rt16[t * 32 + fi] = (_Float16)cs; rt16[t * 32 + 16 + fi] = (_Float16)sn;
        }
    }
}

__device__ __forceinline__ int prefetch_ss_panel(Frame& F, int N) {
    int bx = blockIdx.x; asm volatile("" : "+s"(bx));
    pg8::StaticOrder S; S.init(M, N, F.G, bx); pg8::Unit u; if (!S.next(0, u)) return -1;
    const char* src = (const char*)(F.ws + WS_SS) + (size_t)u.pm * 256 * 64;
#pragma unroll
    for (int i = 0; i < 2; ++i) { const int p = F.wave * 2 + i;
        __builtin_amdgcn_global_load_lds((const GAS unsigned*)(src + p * 1024 + F.lane * 16), (LAS unsigned*)(F.lds + RSTD_OFF + p * 1024), 16, 0, 0); }
    if (F.tid == 0) { LAS int* w = (LAS int*)(F.lds + MISC_OFF + 80); int neg = -1; asm volatile("" : "+v"(neg)); w[0] = u.pm; w[1] = neg; }
    return u.pm;
}
__device__ __forceinline__ void ph3_gate(Frame& F, int l) {
    const float* kmean = (const float*)(F.ws + WS_KMEAN);
    const bf16* Q = (const bf16*)(F.ws + WS_Q);
    gu32* cnt = F.ctl + CW_CNT + l * 512; unsigned* list = (unsigned*)(F.ws + WS_LIST);
    const int lane = F.lane, r32 = lane & 31, hh = lane >> 5;
    LAS int* hist = (LAS int*)(F.lds + XTRA_OFF); LAS int* base = hist + 64;
    LAS float* kml = (LAS float*)(F.lds + RING_OFF);
    for (int it0 = F.vcu; it0 < BATCH * NH * NBLK; it0 += 2 * F.G) {
        f32x16 p[2]; int bqv[2], bhv[2], tv[2]; bool act[2];
        __syncthreads();
#pragma unroll
        for (int i = 0; i < 2; ++i) { const int it = it0 + i * F.G; const bool a_ = it < BATCH * NH * NBLK && (it & 31) != 0; const int bh = (a_ ? it : 1) >> 5;
            const int row = F.tid >> 4, c = F.tid & 15; const float* src = kmean + ((size_t)bh * NBLK + row) * HD + 8 * c;
            const f32x4 v0 = *(const GAS f32x4*)src, v1 = *(const GAS f32x4*)(src + 4);
            LAS float* d = kml + i * (NBLK * 132) + row * 132 + 8 * c; *(LAS f32x4*)d = v0; *(LAS f32x4*)(d + 4) = v1; }
        __syncthreads();
#pragma unroll
        for (int i = 0; i < 2; ++i) {
            const int it = it0 + i * F.G; act[i] = it < BATCH * NH * NBLK && (it & 31) != 0;
            const int itc = act[i] ? it : 1;
            const int bq = itc & 31, bh = itc >> 5, b = bh >> 3, h = bh & 7;
            bqv[i] = bq; bhv[i] = bh; tv[i] = bq * MOBA + F.wave * 32 + r32;
            const bf16* qrow = Q + ((size_t)b * SEQ + tv[i]) * DM + h * HD;
            const LAS float* kmr = kml + i * (NBLK * 132) + r32 * 132;
            p[i] = (f32x16){0.f, 0.f, 0.f, 0.f, 0.f, 0.f, 0.f, 0.f, 0.f, 0.f, 0.f, 0.f, 0.f, 0.f, 0.f, 0.f};
            if (act[i]) {
#pragma unroll
                for (int ds = 0; ds < 8; ++ds) {
                    const bf16x8 qf = *(const GAS bf16x8*)(qrow + 16 * ds + 8 * hh);
                    const f32x4 k0 = *(const LAS f32x4*)(kmr + 16 * ds + 8 * hh), k1 = *(const LAS f32x4*)(kmr + 16 * ds + 8 * hh + 4);
                    v4u hi, lo;
                    hi.x = cvt_pk_bf16(k0.x, k0.y); hi.y = cvt_pk_bf16(k0.z, k0.w); hi.z = cvt_pk_bf16(k1.x, k1.y); hi.w = cvt_pk_bf16(k1.z, k1.w);
                    lo.x = cvt_pk_bf16(k0.x - bf_lo(hi.x), k0.y - bf_hi(hi.x)); lo.y = cvt_pk_bf16(k0.z - bf_lo(hi.y), k0.w - bf_hi(hi.y));
                    lo.z = cvt_pk_bf16(k1.x - bf_lo(hi.z), k1.y - bf_hi(hi.z)); lo.w = cvt_pk_bf16(k1.z - bf_lo(hi.w), k1.w - bf_hi(hi.w));
                    p[i] = __builtin_amdgcn_mfma_f32_32x32x16_bf16(__builtin_bit_cast(bf16x8, hi), qf, p[i], 0, 0, 0);
                    p[i] = __builtin_amdgcn_mfma_f32_32x32x16_bf16(__builtin_bit_cast(bf16x8, lo), qf, p[i], 0, 0, 0);
                }
            }
#pragma unroll
            for (int r = 0; r < 16; ++r) if ((r & 3) + 8 * (r >> 2) + 4 * hh >= bq) p[i][r] = -INFINITY;
        }
        __syncthreads();
        if (F.tid < 64) hist[F.tid] = 0;
        __syncthreads();
        int pn[2][3], pp[2][3];
#pragma unroll
        for (int i = 0; i < 2; ++i) { const int nv = act[i] ? (bqv[i] < 3 ? bqv[i] : 3) : 0;
#pragma unroll
            for (int rk = 0; rk < 3; ++rk) { pn[i][rk] = -1; pp[i][rk] = 0; if (rk < nv) {
                float best = -INFINITY; int bi = 64;
#pragma unroll
                for (int r = 0; r < 16; ++r) { const int n = (r & 3) + 8 * (r >> 2) + 4 * hh; if (p[i][r] > best) { best = p[i][r]; bi = n; } }
                const float ob = __shfl_xor(best, 32); const int oi = __shfl_xor(bi, 32);
                if (ob > best || (ob == best && oi < bi)) { best = ob; bi = oi; }
#pragma unroll
                for (int r = 0; r < 16; ++r) if ((r & 3) + 8 * (r >> 2) + 4 * hh == bi) p[i][r] = -INFINITY;
                pn[i][rk] = bi; if (hh == 0) pp[i][rk] = atomicAdd((int*)(hist + i * 32 + bi), 1); } } }
        __syncthreads();
        if (F.tid < 64) { const int i = F.tid >> 5, n = F.tid & 31; const int c = hist[F.tid]; const int bh = i ? bhv[1] : bhv[0];
            base[F.tid] = c ? (int)__hip_atomic_fetch_add(cnt + bh * NBLK + n, (unsigned)c, RLX_AGENT) : 0; }
        __syncthreads();
        if (hh == 0) {
#pragma unroll
            for (int i = 0; i < 2; ++i) { const int nv = act[i] ? (bqv[i] < 3 ? bqv[i] : 3) : 0;
#pragma unroll
                for (int rk = 0; rk < 3; ++rk) if (rk < nv) list[(size_t)(bhv[i] * NBLK + pn[i][rk]) * SEQ + base[i * 32 + pn[i][rk]] + pp[i][rk]] = (unsigned)tv[i] | ((unsigned)rk << 13); }
        }
    }
}

__device__ __forceinline__ int koff(int r, int c) { return r * 256 + ((c ^ (r & 15)) << 4); }
__device__ __forceinline__ int voff(int r, int c) { return r * 256 + ((((c >> 2) ^ (r & 3)) << 6) | ((c & 3) << 4)); }
__device__ __forceinline__ void load_kv_block(Frame& F, const bf16* K, const bf16* V, size_t row0, int h) {
    LAS unsigned char* lk = F.lds + RING_OFF;
    int lane = F.lane; asm volatile("" : "+v"(lane));
    const int rl = lane >> 4, pos = lane & 15;
    const char* kb = (const char*)(K + row0 * DM + h * HD); const char* vb = (const char*)(V + row0 * DM + h * HD);
#pragma unroll
    for (int i = 0; i < 8; ++i) {
        const int p = F.wave + 8 * i, r = 4 * p + rl;
        const unsigned ksrc = (unsigned)(r * (DM * 2) + ((pos ^ (r & 15)) << 4));
        const unsigned vsrc = (unsigned)(r * (DM * 2) + (((((pos >> 2) ^ (r & 3)) << 2) | (pos & 3)) << 4));
        __builtin_amdgcn_global_load_lds((const GAS unsigned*)(kb + ksrc), (LAS unsigned*)(lk + p * 1024), 16, 0, 0);
        __builtin_amdgcn_global_load_lds((const GAS unsigned*)(vb + vsrc), (LAS unsigned*)(lk + 65536 + p * 1024), 16, 0, 0);
    }
    asm volatile("s_waitcnt vmcnt(0)" ::: "memory");
    __syncthreads();
}
__device__ __forceinline__ void sm_tile(f32x16& p, bool dg, int hh, int r32, float& ls, bf16x8& pa0, bf16x8& pa1) {
#pragma unroll
    for (int r = 0; r < 16; ++r) { float e = __builtin_amdgcn_exp2f(p[r]); if (dg && ((r & 3) + 8 * (r >> 2) + 4 * hh) > r32) e = 0.f; p[r] = e; ls += e; }
    v4u pw0, pw1;
    pw0.x = cvt_pk_bf16(p[0], p[1]); pw0.y = cvt_pk_bf16(p[2], p[3]); pw0.z = cvt_pk_bf16(p[4], p[5]); pw0.w = cvt_pk_bf16(p[6], p[7]);
    pw1.x = cvt_pk_bf16(p[8], p[9]); pw1.y = cvt_pk_bf16(p[10], p[11]); pw1.z = cvt_pk_bf16(p[12], p[13]); pw1.w = cvt_pk_bf16(p[14], p[15]);
    pa0 = __builtin_bit_cast(bf16x8, pw0); pa1 = __builtin_bit_cast(bf16x8, pw1);
}
template <bool DIAG, bool OT>
__device__ __forceinline__ void attn_core(LAS unsigned char* lds, const bf16x8 (&qf)[8], int ntiles, f32x16 (&o)[4], float& ls, int lane) {
    const int r32 = lane & 31, hh = lane >> 5;
    const int kbase = r32 * 256, kx = r32 & 15;
    const int q_ = (lane & 15) >> 2, p_ = lane & 3, g1 = (lane >> 4) & 1;
    int vb[4];
#pragma unroll
    for (int d = 0; d < 4; ++d) vb[d] = 65536 + (4 * hh + q_) * 256 + ((d ^ q_) << 6) + 32 * g1 + 8 * p_;
#define SB() __builtin_amdgcn_sched_barrier(0)
#define LOADK(KT) { const LAS unsigned char* kp_ = lds + (KT) * 8192 + kbase; _Pragma("unroll") for (int ds = 0; ds < 8; ++ds) kf[ds] = *(const LAS bf16x8*)(kp_ + (((2 * ds + hh) ^ kx) << 4)); }
#define QKM(P) { P = (f32x16){0.f, 0.f, 0.f, 0.f, 0.f, 0.f, 0.f, 0.f, 0.f, 0.f, 0.f, 0.f, 0.f, 0.f, 0.f, 0.f}; _Pragma("unroll") for (int ds = 0; ds < 8; ++ds) P = __builtin_amdgcn_mfma_f32_32x32x16_bf16(kf[ds], qf[ds], P, 0, 0, 0); }
#define LOADV(VF, KT, D0) { _Pragma("unroll") for (int dd = 0; dd < 2; ++dd) _Pragma("unroll") for (int s2 = 0; s2 < 2; ++s2) { const LAS unsigned char* vp_ = lds + (KT) * 8192 + vb[(D0) + dd] + s2 * 4096; \
        const v4i16_t lo_ = __builtin_amdgcn_ds_read_tr16_b64_v4i16((LAS v4i16_t*)vp_); const v4i16_t hi_ = __builtin_amdgcn_ds_read_tr16_b64_v4i16((LAS v4i16_t*)(vp_ + 2048)); \
        VF[dd * 2 + s2] = (bf16x8){lo_[0], lo_[1], lo_[2], lo_[3], hi_[0], hi_[1], hi_[2], hi_[3]}; } }
#define PVM(VF, D0) { _Pragma("unroll") for (int dd = 0; dd < 2; ++dd) { o[(D0) + dd] = __builtin_amdgcn_mfma_f32_32x32x16_bf16(OT ? VF[dd * 2] : pa0, OT ? pa0 : VF[dd * 2], o[(D0) + dd], 0, 0, 0); o[(D0) + dd] = __builtin_amdgcn_mfma_f32_32x32x16_bf16(OT ? VF[dd * 2 + 1] : pa1, OT ? pa1 : VF[dd * 2 + 1], o[(D0) + dd], 0, 0, 0); } }
    bf16x8 kf[8];
    LOADK(0)
    f32x16 pn; QKM(pn)
    if (ntiles > 1) LOADK(1)
    for (int kt = 0; kt < ntiles; ++kt) {
        const bool last = kt + 1 >= ntiles;
        f32x16 p = pn;
        bf16x8 va[4], vc[4], pa0, pa1;
        LOADV(va, kt, 0)
        SB();
        if (!last) QKM(pn)
        sm_tile(p, DIAG && last, hh, r32, ls, pa0, pa1);
        LOADV(vc, kt, 2)
        SB();
        PVM(va, 0)
        if (kt + 2 < ntiles) LOADK(kt + 2)
        SB();
        PVM(vc, 2)
    }
#undef SB
#undef LOADK
#undef QKM
#undef LOADV
#undef PVM
}
constexpr int STG_ROW = 272, STG_WAVE = 8 * STG_ROW;
__device__ __forceinline__ void stage_round(LAS unsigned char* stg, const f32x16 (&o)[4], int k, int lane, v4u (&pc)[2]) {
    const int r32 = lane & 31, hh = lane >> 5;
#pragma unroll
    for (int rr = 0; rr < 4; ++rr)
#pragma unroll
        for (int d = 0; d < 4; ++d) *(LAS unsigned short*)(stg + (rr + 4 * hh) * STG_ROW + (32 * d + r32) * 2) = (unsigned short)(cvt_pk_bf16(o[d][4 * k + rr], 0.f) & 0xffffu);
    LDS_WAIT(); asm volatile("" ::: "memory");
#pragma unroll
    for (int j = 0; j < 2; ++j) { const int sl = lane + 64 * j; pc[j] = *(const LAS v4u*)(stg + (sl >> 4) * STG_ROW + (sl & 15) * 16); }
    LDS_WAIT(); asm volatile("" ::: "memory");
}
__device__ __forceinline__ void ph4_sparse(Frame& F, int l) {
    const bf16* Q = (const bf16*)(F.ws + WS_Q); const bf16* K = (const bf16*)(F.ws + WS_K); const bf16* V = (const bf16*)(F.ws + WS_V);
    bf16* PART = (bf16*)(F.ws + WS_PART); float* LP = (float*)(F.ws + WS_LPART);
    const unsigned* list = (const unsigned*)(F.ws + WS_LIST); gu32* cnt = F.ctl + CW_CNT + l * 512;
    LAS int* pre = (LAS int*)(F.lds + XTRA_OFF);
    LAS unsigned* ent = (LAS unsigned*)(F.lds + XTRA_OFF + 4096) + F.wave * 32;
    const int lane = F.lane, r32 = lane & 31, hh = lane >> 5;
    constexpr int LOADW = 5;
    const int myc = (int)__hip_atomic_load(cnt + F.tid, RLX_AGENT);
    { int v = myc ? LOADW + 8 * ((myc + 255) >> 8) : 0;
#pragma unroll
      for (int off = 1; off < 64; off <<= 1) { const int t = __shfl_up(v, off); if (lane >= off) v += t; }
      LAS int* wsum = pre + 512;
      if (lane == 63) wsum[F.wave] = v;
      __syncthreads();
      int base = 0;
#pragma unroll
      for (int w = 0; w < NWAVES - 1; ++w) base += (w < F.wave) ? wsum[w] : 0;
      pre[F.tid] = v + base;
      __syncthreads(); }
    const int T = pre[511];
    const int lo = (int)(((long)F.vcu * T) / F.G), hi = (int)(((long)(F.vcu + 1) * T) / F.G);
    LAS unsigned char* stg = F.lds + STG_OFF + F.wave * STG_WAVE;
    int it = lo;
    while (it < hi) {
        int a = 0, bnd = 511;
        while (a < bnd) { const int mid = (a + bnd) >> 1; if (pre[mid] > it) bnd = mid; else a = mid + 1; }
        const int bhn = a, first = bhn ? pre[bhn - 1] : 0, cost = pre[bhn] - first, R = (cost - LOADW) >> 3;
        const int pa = it - first, pb = (hi < pre[bhn] ? hi : pre[bhn]) - first;
        it = first + pb;
        int ra = (pa - LOADW + 7) >> 3; ra = ra < 0 ? 0 : ra; int rb = (pb - LOADW + 7) >> 3; rb = rb < 0 ? 0 : (rb > R ? R : rb);
        if (pb == cost) rb = R;
        if (rb <= ra) continue;
        const int bh = bhn >> 5, n = bhn & 31, b = bh >> 3, h = bh & 7;
        const int c_tot = (int)__hip_atomic_load(cnt + bhn, RLX_AGENT);
        PSUB_BEGIN(200);
        __syncthreads();
        load_kv_block(F, K, V, (size_t)b * SEQ + n * MOBA, h);
        PSUB_END(200);
        const int s1 = (c_tot + 31) >> 5;
        const int send = 8 * rb < s1 ? 8 * rb : s1;
        const unsigned* lst = list + (size_t)bhn * SEQ;
        const bf16* Qh = Q + (size_t)b * SEQ * DM + h * HD + 8 * hh;
        for (int sc = 8 * ra + F.wave; sc < send; sc += NWAVES) {
            const int idx = sc * 32 + r32;
            const unsigned e = idx < c_tot ? lst[idx] : 0xffffffffu;
            const bool valid = e != 0xffffffffu;
            const size_t qr = valid ? (e & 8191u) : 0u;
            bf16x8 qf[8];
#pragma unroll
            for (int ds = 0; ds < 8; ++ds) qf[ds] = *(const GAS bf16x8*)(Qh + qr * DM + 16 * ds);
            f32x16 o[4];
#pragma unroll
            for (int d = 0; d < 4; ++d)
#pragma unroll
                for (int r = 0; r < 16; ++r) o[d][r] = 0.f;
            float ls = 0.f;
            PSUB_BEGIN(202);
            attn_core<false, true>(F.lds + RING_OFF, qf, 8, o, ls, lane);
            PSUB_END(202); PSUB_BEGIN(203);
            ls += __shfl_xor(ls, 32);
            if (valid && hh == 0) LP[((size_t)(e >> 13) * M + (size_t)b * SEQ + qr) * NH + h] = ls;
            char* prow = (char*)(PART + ((size_t)(valid ? (e >> 13) : 0u) * M + (size_t)b * SEQ + qr) * DM + h * HD) + 16 * hh;
#pragma unroll
            for (int d = 0; d < 4; ++d)
#pragma unroll
                for (int jj = 0; jj < 2; ++jj) {
                    unsigned ax = cvt_pk_bf16(o[d][8 * jj + 0], o[d][8 * jj + 1]), ay = cvt_pk_bf16(o[d][8 * jj + 2], o[d][8 * jj + 3]);
                    unsigned bx = cvt_pk_bf16(o[d][8 * jj + 4], o[d][8 * jj + 5]), by = cvt_pk_bf16(o[d][8 * jj + 6], o[d][8 * jj + 7]);
                    { auto r = __builtin_amdgcn_permlane32_swap(ax, bx, false, false); ax = r[0]; bx = r[1]; }
                    { auto r = __builtin_amdgcn_permlane32_swap(ay, by, false, false); ay = r[0]; by = r[1]; }
                    if (valid) *(GAS v4u*)(prow + 32 * (2 * d + jj)) = (v4u){ax, ay, bx, by};
                }
            PSUB_END(203);
        }
    }
}

__device__ __forceinline__ void ph5_diag(Frame& F, int l, int own_pm, int own_hp) {
    bf16* Q = (bf16*)(F.ws + WS_Q); const bf16* K = (const bf16*)(F.ws + WS_K); const bf16* V = (const bf16*)(F.ws + WS_V);
    const bf16* PART = (const bf16*)(F.ws + WS_PART); const float* LP = (const float*)(F.ws + WS_LPART);
    LAS float* lsh = (LAS float*)(F.lds + XTRA_OFF) + F.wave * 32;
    LAS unsigned char* stg = F.lds + STG_OFF + F.wave * STG_WAVE;
    const int it_beg = own_pm >= 0 ? (((own_pm >> 5) * NH + 2 * own_hp) * NBLK + (own_pm & 31)) : F.vcu, it_step = own_pm >= 0 ? NBLK : F.G, it_end = own_pm >= 0 ? it_beg + 2 * NBLK : BATCH * NH * NBLK;
    for (int it = it_beg; it < it_end; it += it_step) {
        int lane = F.lane; asm volatile("" : "+v"(lane));
        const int r32 = lane & 31, hh = lane >> 5;
        const int bq = it & 31, bh = it >> 5, b = bh >> 3, h = bh & 7;
        const size_t row0 = (size_t)b * SEQ + bq * MOBA;
        const int sb = F.wave < 4 ? 7 - F.wave : F.wave - 4;
        const size_t qrow = row0 + sb * 32 + r32;
        bf16x8 qf[8];
#pragma unroll
        for (int ds = 0; ds < 8; ++ds) qf[ds] = *(const GAS bf16x8*)(Q + qrow * DM + h * HD + 16 * ds + 8 * hh);
        const int nv = bq < 3 ? bq : 3;
        float lsum_part = 0.f;
        for (int j = 0; j < nv; ++j) lsum_part += LP[((size_t)j * M + qrow) * NH + h];
        PSUB_BEGIN(210);
        __syncthreads();
        load_kv_block(F, K, V, row0, h);
        PSUB_END(210); PSUB_BEGIN(211);
        f32x16 o[4];
#pragma unroll
        for (int d = 0; d < 4; ++d)
#pragma unroll
            for (int r = 0; r < 16; ++r) o[d][r] = 0.f;
        float ls = 0.f;
        attn_core<true, false>(F.lds + RING_OFF, qf, sb + 1, o, ls, lane);
        asm volatile("" ::: "memory"); __builtin_amdgcn_sched_barrier(0);
        PSUB_END(211); PSUB_BEGIN(212);
        ls += __shfl_xor(ls, 32);
        ls += lsum_part;
        if (hh == 0) lsh[r32] = 1.f / ls;
        const bf16* pbase = PART + (row0 + sb * 32) * DM + h * HD;
        v4u pl[2][3][2];
#define PL_LOAD(buf, k) _Pragma("unroll") for (int s3 = 0; s3 < 3; ++s3) _Pragma("unroll") for (int j = 0; j < 2; ++j) { const int sl = lane + 64 * j; \
            pl[buf][s3][j] = (v4u){0u, 0u, 0u, 0u}; if (s3 < nv) pl[buf][s3][j] = *(const GAS v4u*)(pbase + (size_t)s3 * M * DM + (size_t)(8 * (k) + (sl >> 4)) * DM + 8 * (sl & 15)); }
        PL_LOAD(0, 0)
#pragma unroll
        for (int k = 0; k < 4; ++k) {
            if (k == 0) { PL_LOAD(1, 1) } else if (k == 1) { PL_LOAD(0, 2) } else if (k == 2) { PL_LOAD(1, 3) }
            v4u pc[2]; stage_round(stg, o, k, lane, pc);
#pragma unroll
            for (int j = 0; j < 2; ++j) { const int sl = lane + 64 * j, ql = 8 * k + (sl >> 4); const size_t rw = row0 + sb * 32 + ql;
                pg8::f32x4 a0, a1; pg8::unpack8(pc[j], a0, a1);
#pragma unroll
                for (int s3 = 0; s3 < 3; ++s3) { pg8::f32x4 b0, b1; pg8::unpack8(pl[k & 1][s3][j], b0, b1); a0 += b0; a1 += b1; }
                const float inv = lsh[ql];
                *(GAS v4u*)(Q + rw * DM + h * HD + 8 * (sl & 15)) = pg8::pack8(a0 * inv, a1 * inv); }
        }
#undef PL_LOAD
        PSUB_END(212);
    }
}

__device__ __forceinline__ void ph7_conv(Frame& F, int l) {
    const bf16* GLU = (const bf16*)(F.ws + WS_GLU); const bf16* SZC = (const bf16*)(F.ws + WS_SZC); bf16* C = (bf16*)(F.ws + WS_AC) + DM;
    const float* cw = ARG_IN(6) + (size_t)l * CK * DM; const float* cb = ARG_IN(7) + (size_t)l * DM; const float* cg = ARG_IN(8) + (size_t)l * DM; const float* cbeta = ARG_IN(9) + (size_t)l * DM;
    LAS unsigned* tile = (LAS unsigned*)(F.lds + RING_OFF);
    LAS float* red = (LAS float*)(F.lds + XTRA_OFF);
    LAS float* stat = red + 512;
    const int tid = F.tid, lane = F.lane;
    constexpr int TT = 8;
    float w0[CK], w1[CK];
#pragma unroll
    for (int j = 0; j < CK; ++j) { const f32x2v wv = *(const GAS f32x2v*)(cw + (size_t)j * DM + 2 * tid); w0[j] = wv.x; w1[j] = wv.y; }
    const f32x2v bv = *(const GAS f32x2v*)(cb + 2 * tid), gv = *(const GAS f32x2v*)(cg + 2 * tid), bev = *(const GAS f32x2v*)(cbeta + 2 * tid);
    for (int it = F.vcu; it < M / 32; it += F.G) {
        const int tok0 = it * 32, t0 = tok0 & (SEQ - 1);
        __syncthreads();
        PSUB_BEGIN(100);
        {
            const int zr = t0 < 30 ? 30 - t0 : 0;
            const char* src = (const char*)(GLU + (size_t)(tok0 - 30) * DM);
#pragma unroll 4
            for (int p = F.wave; p < 124; p += NWAVES) {
                if (2 * zr > p) { *(LAS v4u*)((LAS unsigned char*)tile + p * 1024 + lane * 16) = (v4u){0u, 0u, 0u, 0u}; }
                else __builtin_amdgcn_global_load_lds((const GAS unsigned*)(src + (size_t)p * 1024 + lane * 16), (LAS unsigned*)((LAS unsigned char*)tile + p * 1024), 16, 0, 0);
            }
            asm volatile("s_waitcnt vmcnt(0)" ::: "memory");
        }
        __syncthreads();
        PSUB_END(100); PSUB_BEGIN(101);
        float a0[32], a1[32];
#pragma unroll
        for (int hf = 0; hf < 32 / TT; ++hf) {
#pragma unroll
            for (int tt = 0; tt < TT; ++tt) { a0[hf * TT + tt] = bv.x; a1[hf * TT + tt] = bv.y; }
#pragma unroll
            for (int i = 0; i < TT + 30; ++i) { const unsigned w = tile[(hf * TT + i) * 512 + tid]; const float x0 = bf_lo(w), x1 = bf_hi(w);
#pragma unroll
                for (int tt = 0; tt < TT; ++tt) if (i - tt >= 0 && i - tt < CK) { a0[hf * TT + tt] += w0[i - tt] * x0; a1[hf * TT + tt] += w1[i - tt] * x1; }
                if ((i & 7) == 7) __builtin_amdgcn_sched_barrier(0); }
            float rv[2 * TT];
#pragma unroll
            for (int tt = 0; tt < TT; ++tt) { const float p0 = a0[hf * TT + tt], p1 = a1[hf * TT + tt]; rv[2 * tt] = p0 + p1; rv[2 * tt + 1] = p0 * p0 + p1 * p1; }
#define TR_STEP(MM) { const bool up = (lane & (MM)) != 0; _Pragma("unroll") for (int i = 0; i < (MM); ++i) { const float send = up ? rv[i] : rv[i + (MM)], keep = up ? rv[i + (MM)] : rv[i]; rv[i] = keep + __shfl_xor(send, (MM)); } }
            static_assert(TT == 8, "transpose-reduce steps are written out for 16 values");
            TR_STEP(8) TR_STEP(4) TR_STEP(2) TR_STEP(1)
#undef TR_STEP
            rv[0] += __shfl_xor(rv[0], 16); rv[0] += __shfl_xor(rv[0], 32);
            if (lane < 2 * TT) red[F.wave * 64 + hf * 2 * TT + lane] = rv[0];
            __builtin_amdgcn_sched_barrier(0);
        }
        unsigned z[32];
#pragma unroll
        for (int tt = 0; tt < 32; ++tt) z[tt] = *((const GAS unsigned*)(SZC + (size_t)(tok0 + tt) * DM) + tid);
        __syncthreads();
        if (tid < 64) { float s = 0.f;
#pragma unroll
            for (int w = 0; w < 8; ++w) s += red[w * 64 + tid];
            const float other = __shfl_xor(s, 1);
            const float mean = ((tid & 1) ? other : s) * (1.f / DM), ex2 = ((tid & 1) ? s : other) * (1.f / DM);
            const float var = fmaxf(ex2 - mean * mean, 0.f);
            stat[tid] = (tid & 1) ? 1.f / sqrtf(var + EPS) : mean; }
        __syncthreads();
        PSUB_END(101); PSUB_BEGIN(102);
#pragma unroll
        for (int tt = 0; tt < 32; ++tt) {
            const float mean = stat[2 * tt], rstd = stat[2 * tt + 1];
            const float y0 = (a0[tt] - mean) * rstd * gv.x + bev.x, y1 = (a1[tt] - mean) * rstd * gv.y + bev.y;
            *((GAS unsigned*)(C + (size_t)(tok0 + tt) * (2 * DM)) + tid) = cvt_pk_bf16(silu(y0) * bf_lo(z[tt]), silu(y1) * bf_hi(z[tt]));
        }
        PSUB_END(102);
    }
}

#ifndef ONLY_PHASE
#define ONLY_PHASE -1
#endif
#ifndef ONLY_SUB
#define ONLY_SUB 0
#endif
#define SUB(k) (ONLY_SUB == 0 || ONLY_SUB == (k))
#ifndef STAG6
#define STAG6 0u
#endif
#define ONLY(k) (ONLY_PHASE < 0 || ONLY_PHASE == (k))
__global__ void __launch_bounds__(NWAVES * 64, 2) hybrid_fwd(Args args) {
    extern __shared__ __attribute__((aligned(16))) unsigned char lds[];
    Frame F;
    F.lds = (LAS unsigned char*)lds;
    F.MISC = (volatile LAS unsigned*)(F.lds + MISC_OFF);
    F.tid = threadIdx.x; F.lane = F.tid & 63; F.wave = __builtin_amdgcn_readfirstlane(F.tid >> 6);
    F.G = gridDim.x; { const int bx = blockIdx.x; F.vcu = (F.G % 8 == 0) ? (bx % 8) * (F.G / 8) + bx / 8 : bx; }
    F.ws = args.ws; F.ctl = (gu32*)(args.ws + WS_CTL);
    for (int u = F.tid; u < (LDS_BYTES - LDSCTL_OFF) / 4; u += NWAVES * 64) ((LAS unsigned*)(F.lds + LDSCTL_OFF))[u] = 0u;
    __syncthreads();
    XcdBarrier bar; bar.bar = (unsigned*)(F.ctl + CW_BAR); bar.x = 0; bar.st = nullptr;
#if !MK_PER_PHASE
    bar = xcd_barrier_post((unsigned*)(F.ctl + CW_BAR), F.MISC + 8);
#endif
#if MK_PER_PHASE
#define GRID_BAR() do { } while (0)
#else
#define GRID_BAR() xcd_barrier(bar)
#endif
    const int lo = args.ph_lo, hi = args.ph_hi;
    unsigned long long probe_t0 = 0, probe_acc = 0; F.pacc = 0; F.pt0 = 0; unsigned pt32 = 0; unsigned long long clk_t0 = 0, clk_c0 = 0, clk_t = 0, clk_c = 0;
#define WT ((bf16*)(F.ws + WS_WT))
#define XN ((bf16*)(F.ws + WS_XN))
#define Qb ((bf16*)(F.ws + WS_Q))
#define GA ((bf16*)(F.ws + WS_GA))
#define GLU ((bf16*)(F.ws + WS_GLU))
#define SZC ((bf16*)(F.ws + WS_SZC))
#define GC ((bf16*)(F.ws + WS_GC))
#define ACb ((bf16*)(F.ws + WS_AC))
#define MB ((bf16*)(F.ws + WS_MB))
#define PH_BEGIN(k) if (ONLY(k) && lo <= l * NPHASE_L + (k) && l * NPHASE_L + (k) < hi) { { int t_ = threadIdx.x; asm volatile("" : "+v"(t_)); F.tid = t_; F.lane = t_ & 63; F.wave = __builtin_amdgcn_readfirstlane(t_ >> 6); GAS unsigned char* w_ = (GAS unsigned char*)args.ws; asm volatile("" : "+s"(w_)); F.ws = (unsigned char*)w_; F.ctl = (gu32*)(w_ + WS_CTL); } if (PROBE_PHASE == (k)) probe_t0 = rt(); if (PROBE_PHASE == 700 + (k)) pt32 = (unsigned)rt(); if (PROBE_PHASE == 600 + (k)) { clk_t0 = rt(); clk_c0 = __builtin_amdgcn_s_memtime(); }
#define PH_END_NOBAR(k) if (PROBE_PHASE == (k)) { const unsigned long long t1_ = rt(); probe_acc += t1_ - probe_t0; } if (PROBE_PHASE == 600 + (k)) { clk_t += rt() - clk_t0; clk_c += __builtin_amdgcn_s_memtime() - clk_c0; } }
#define PH_END(k) if (PROBE_PHASE == 700 + (k)) { if (F.tid == 0) atomicMax((unsigned*)(F.ctl + 96), (unsigned)rt() - pt32); } if (l * NPHASE_L + (k) + 1 < hi) GRID_BAR(); if (PROBE_PHASE == 500 && l * NPHASE_L + (k) + 1 < hi) GRID_BAR(); if (PROBE_PHASE == (k)) { const unsigned long long t1_ = rt(); probe_acc += t1_ - probe_t0; } if (PROBE_PHASE == 600 + (k)) { clk_t += rt() - clk_t0; clk_c += __builtin_amdgcn_s_memtime() - clk_c0; } }
#pragma unroll 1
    for (int l = 0; l < DEPTH; ++l) {
        PH_BEGIN(0) { ph0_prologue(F, l, (l == 0) ? ARG_IN(0) : (const float*)ARG_OUT); }
        PH_END(0)
        PH_BEGIN(1) { (void)prefetch_ss_panel(F, 3072); pg8::Gemm g{XN, WT + WT_B * DM, M, 3072, DM}; pg8::StaticOrder S; S.init(M, 3072, F.G, (int)blockIdx.x);
            pg8::EpiQKV E{Qb, (size_t)(WS_K - WS_Q) / 2, ARG_IN(4) + (size_t)l * HD, ARG_IN(5) + (size_t)l * HD, (const unsigned short*)(F.ws + WS_ROPE),
                          (float*)(F.ws + WS_KMEAN), QSCALE, F.lds + XTRA_OFF, SEQ, pg8::RowRstd{(LAS float*)(F.lds + RSTD_OFF), (LAS float*)(F.lds + RTAB_OFF), (LAS int*)(F.lds + MISC_OFF + 80), (const float*)(F.ws + WS_SS)}};
            pg8::gemm_phase<pg8::EpiQKV, pg8::StaticOrder, true, PG8_SP2>(F.lds + RING_OFF, g, S, E); }
        PH_END(1)
        PH_BEGIN(3) { ph3_gate(F, l); }
        PH_END(3)
        PH_BEGIN(4) { ph4_sparse(F, l); }
        PH_END(4)
        PH_BEGIN(5) { if (F.G != 256) { ph5_diag(F, l, -1, 0); GRID_BAR(); } }
        PH_END_NOBAR(5)
        PH_BEGIN(6) { if (F.G == 256) { int bx = blockIdx.x; asm volatile("" : "+s"(bx)); pg8::StaticOrder S0; S0.init(M, 6144, F.G, bx); pg8::Unit u0; (void)S0.next(0, u0);
                ph5_diag(F, l, u0.pm, u0.pn & 3); asm volatile("s_waitcnt vmcnt(0)" ::: "memory"); __syncthreads();
                if (F.tid == 0) (void)__hip_atomic_fetch_add(F.ctl + CW_DDONE + l * 64, 1u, __ATOMIC_RELAXED, __HIP_MEMORY_SCOPE_AGENT); }
            (void)prefetch_ss_panel(F, 6144); pg8::Gemm g{XN, WT + WT_C * DM, M, 6144, DM}; pg8::StaticOrder S; S.init(M, 6144, F.G, (int)blockIdx.x);
            pg8::EpiCA E{pg8::EpiC{Qb, ACb, GA, ARG_IN(3) + (size_t)l * 2 * DM}, pg8::EpiA{GLU, SZC, GC, ARG_IN(3) + (size_t)l * 2 * DM + DM}, pg8::RowRstd{(LAS float*)(F.lds + RSTD_OFF), (LAS float*)(F.lds + RTAB_OFF), (LAS int*)(F.lds + MISC_OFF + 80), (const float*)(F.ws + WS_SS)}, F.ctl + CW_DDONE + l * 64, F.G == 256 ? 256u : 0u};
            pg8::gemm_phase<pg8::EpiCA, pg8::StaticOrder, PG8_ALIGN, PG8_SP2>(F.lds + RING_OFF, g, S, E); }
        PH_END(6)
        PH_BEGIN(7) { ph7_conv(F, l); }
        PH_END(7)
        PH_BEGIN(8) { pg8::Gemm g{ACb, WT + WT_PA * DM, M, DM, 2 * DM}; pg8::StaticOrder S; S.init(M, DM, F.G, (int)blockIdx.x);
            pg8::EpiM E{MB, GA, GC};
            pg8::gemm_phase<pg8::EpiM, pg8::StaticOrder, PG8_ALIGN, PG8_SP2>(F.lds + RING_OFF, g, S, E); }
        PH_END(8)
        PH_BEGIN(9) { pg8::Gemm g{MB, l == 0 ? WT + WT_O * DM : (bf16*)(F.ws + WS_WO1), M, DM, DM}; pg8::StaticOrder S; S.init(M, DM, F.G, (int)blockIdx.x);
            pg8::EpiOut E{(l == 0) ? ARG_IN(0) : (const float*)ARG_OUT, ARG_OUT, (l + 1 < DEPTH) ? XN : (bf16*)nullptr, ARG_IN(1) + (size_t)(l + 1 < DEPTH ? l + 1 : l) * DM, (float*)(F.ws + WS_SS)};
            pg8::gemm_phase<pg8::EpiOut, pg8::StaticOrder, PG8_ALIGN, PG8_SP2>(F.lds + RING_OFF, g, S, E); }
        PH_END_NOBAR(9)
    }
    if (PROBE_PHASE == 400 || PROBE_PHASE == 401) F.pacc += F.MISC[16];
    if (PROBE_PHASE >= 700 && PROBE_PHASE < 800) F.pacc += __hip_atomic_load(F.ctl + 96, RLX_AGENT);
    if (PROBE_PHASE >= 600) F.pacc += (clk_t ? (clk_c * 125ull) / clk_t : 0ull);
    if (PROBE_PHASE >= 0 && blockIdx.x == 0) { const unsigned long long t0_ = rt(); while (rt() - t0_ < 8ull * (probe_acc + F.pacc)) __builtin_amdgcn_s_sleep(8); }
}

extern "C" void kernel_launch(void* const* d_in, const int* in_sizes, int n_in, void* d_out, int out_size, void* d_ws, size_t ws_size, hipStream_t stream) {
    static int grid = 0;
    if (grid == 0) {
        if (n_in != 13 || in_sizes[0] != M * DM || out_size != M * DM || ws_size < WS_END) {
            fprintf(stderr, "kernel_launch: built for 13 inputs, x/out of %d floats, >= %zu bytes of workspace; got n_in %d, in0 %d, out %d, ws %zu; nothing launched\n", M * DM, (size_t)WS_END, n_in, n_in > 0 ? in_sizes[0] : -1, out_size, ws_size);
            grid = -1; return; }
        int dev = 0, cus = 0, per_cu = 0;
        if (hipGetDevice(&dev) != hipSuccess || hipDeviceGetAttribute(&cus, hipDeviceAttributeMultiprocessorCount, dev) != hipSuccess) { fprintf(stderr, "kernel_launch: device query failed\n"); grid = -1; return; }
        if (hipFuncSetAttribute((const void*)hybrid_fwd, hipFuncAttributeMaxDynamicSharedMemorySize, LDS_BYTES) != hipSuccess) { fprintf(stderr, "kernel_launch: hipFuncSetAttribute failed\n"); grid = -1; return; }
        if (hipOccupancyMaxActiveBlocksPerMultiprocessor(&per_cu, (const void*)hybrid_fwd, NWAVES * 64, LDS_BYTES) != hipSuccess || per_cu < 1)
            fprintf(stderr, "kernel_launch: note: occupancy query reports %d workgroups per CU\n", per_cu);
        (void)hipGetLastError();
        grid = cus;
    }
    if (grid < 0) return;
    if (hipMemsetAsync((char*)d_ws + WS_CTL, 0, CTL_ZERO_BYTES, stream) != hipSuccess) { fprintf(stderr, "kernel_launch: hipMemsetAsync failed\n"); return; }
    Args a{};
    for (int i = 0; i < 13; ++i) a.in[i] = (const float*)d_in[i];
    a.out = (float*)d_out; a.ws = (unsigned char*)d_ws;
#if MK_PER_PHASE
    for (int ph = 0; ph < NPHASES; ++ph) { a.ph_lo = ph; a.ph_hi = ph + 1; hipLaunchKernelGGL(hybrid_fwd, dim3(grid), dim3(NWAVES * 64), LDS_BYTES, stream, a); }
#else
    a.ph_lo = 0; a.ph_hi = NPHASES;
    hipLaunchKernelGGL(hybrid_fwd, dim3(grid), dim3(NWAVES * 64), LDS_BYTES, stream, a);
#endif
    const hipError_t le = hipPeekAtLastError();
    if (le != hipSuccess) fprintf(stderr, "kernel_launch: launch failed: %s\n", hipGetErrorName(le));
}
```
